# Optimizing an MI355X kernel written in HIP

```python
import jax, jax.numpy as jnp
from jax import lax
import numpy as np

D_MODEL = 2048
BATCH = 4
SEQ = 2048
DEPTH = 1
DEC_BATCH = 128
DEC_SEQ = 8
PAST_LEN = 16384
PAGE_SIZE = 128

N_META = 16
MIX_W = D_MODEL
POOL_W = MIX_W // 2
MLSTM_W = MIX_W - POOL_W
POOL_WINDOWS = (2, 4, 8, 16)
N_POOL_GROUPS = len(POOL_WINDOWS)
POOL_GW = POOL_W // N_POOL_GROUPS
POOL_HIST = max(POOL_WINDOWS) - 1
N_HEADS = 4
HEAD_DIM = MLSTM_W // N_HEADS
CHUNK = 64
D_FF = -(-8 * D_MODEL // (3 * 256)) * 256
IN_W = POOL_W + 4 * MLSTM_W + 2 * N_HEADS
EPS = 1e-6

kernel_name = 'hymba_pool_mlstm_decoder_step'


def rmsnorm(x, w):
    xf = x.astype(jnp.float32)
    y = xf * lax.rsqrt(jnp.mean(xf * xf, axis=-1, keepdims=True) + EPS)
    return (y * w.astype(jnp.float32)).astype(x.dtype)


def pool_mix(u_prev, u_new, pos0, w_pool, scale):
    B, T, _ = u_new.shape
    ext = jnp.concatenate([u_prev.astype(u_new.dtype), u_new], axis=1)
    cs = jnp.pad(jnp.cumsum(ext.astype(jnp.float32), axis=1), ((0, 0), (1, 0), (0, 0)))
    end = cs[:, POOL_HIST + 1:]
    pos = pos0 + jnp.arange(T, dtype=jnp.int32)
    u32 = u_new.astype(jnp.float32)
    outs = []
    for g, w in enumerate(POOL_WINDOWS):
        sl = slice(g * POOL_GW, (g + 1) * POOL_GW)
        start = cs[:, POOL_HIST + 1 - w:POOL_HIST + 1 - w + T, sl]
        cnt = jnp.minimum(w, pos + 1).astype(jnp.float32)[None, :, None]
        outs.append((end[..., sl] - start) / cnt - u32[..., sl])
    d = jnp.stack(outs, axis=2)
    y = jnp.einsum('btgc,gcd->btgd', d, w_pool.astype(jnp.float32)).reshape(B, T, POOL_W)
    y = y * scale.astype(jnp.float32)
    return y.astype(u_new.dtype), ext[:, -POOL_HIST:]


def _mlstm_chunk(carry, inp):
    C, n, m = carry
    q, k, v, ig, lf = inp
    L = q.shape[-2]
    b = jnp.cumsum(lf, axis=-1)
    a = ig - b
    m_t = jnp.maximum(m[..., None] + b, lax.cummax(a, axis=a.ndim - 1) + b)
    inter = jnp.exp(m[..., None] + b - m_t)
    causal = jnp.tril(jnp.ones((L, L), dtype=bool))
    log_d = a[..., None, :] + (b - m_t)[..., :, None]
    dmat = jnp.exp(jnp.where(causal, log_d, -jnp.inf))
    s = jnp.einsum('bhtd,bhsd->bhts', q, k) * dmat
    num = jnp.einsum('bhts,bhsv->bhtv', s, v) + inter[..., None] * jnp.einsum('bhtd,bhdv->bhtv', q, C)
    qn = s.sum(-1) + inter * jnp.einsum('bhtd,bhd->bht', q, n)
    h = num / jnp.maximum(jnp.abs(qn), jnp.exp(-m_t))[..., None]
    m_new = m_t[..., -1]
    decay = jnp.exp(m + b[..., -1] - m_new)
    w_s = jnp.exp(a + (b[..., -1] - m_new)[..., None])
    C_new = decay[..., None, None] * C + jnp.einsum('bhs,bhsd,bhsv->bhdv', w_s, k, v)
    n_new = decay[..., None] * n + jnp.einsum('bhs,bhsd->bhd', w_s, k)
    return (C_new, n_new, m_new), h


def mlstm_scan(q, k, v, ig, lf, C, n, m, chunk):
    B, H, T, Dh = q.shape
    nc = T // chunk

    def to_chunks(a):
        return jnp.moveaxis(a.reshape(B, H, nc, chunk, *a.shape[3:]), 2, 0)

    (C, n, m), h = lax.scan(_mlstm_chunk, (C, n, m), (to_chunks(q), to_chunks(k), to_chunks(v), to_chunks(ig), to_chunks(lf)))
    h = jnp.moveaxis(h, 0, 2).reshape(B, H, T, Dh)
    return h, C, n, m


def mlstm_mixer(q, k, v, o, gi, gf, C0, n0, m0, segments, b_i, b_f, g_norm):
    B, T, _ = q.shape

    def heads(a):
        return a.reshape(B, T, N_HEADS, HEAD_DIM).transpose(0, 2, 1, 3).astype(jnp.float32)

    qh, kh, vh = heads(q), heads(k) * (HEAD_DIM ** -0.5), heads(v)
    ig = (gi.astype(jnp.float32) + b_i.astype(jnp.float32)).transpose(0, 2, 1)
    lf = jax.nn.log_sigmoid(gf.astype(jnp.float32) + b_f.astype(jnp.float32)).transpose(0, 2, 1)
    C, n, m = C0.astype(jnp.float32), n0.astype(jnp.float32), m0.astype(jnp.float32)
    hs = []
    start = 0
    for length, chunk in segments:
        sl = slice(start, start + length)
        h, C, n, m = mlstm_scan(qh[:, :, sl], kh[:, :, sl], vh[:, :, sl], ig[:, :, sl], lf[:, :, sl], C, n, m, chunk)
        hs.append(h)
        start += length
    h = jnp.concatenate(hs, axis=2)
    h = h * lax.rsqrt(jnp.mean(h * h, axis=-1, keepdims=True) + EPS) * g_norm.astype(jnp.float32).reshape(N_HEADS, 1, HEAD_DIM)
    h = h.transpose(0, 2, 1, 3).reshape(B, T, MLSTM_W)
    y = jax.nn.sigmoid(o.astype(jnp.float32)) * h
    return y.astype(q.dtype), C, n, m


def block(x, pool_prev, C0, n0, m0, pos0, segments, norm_mix_w, w_in, b_i, b_f, w_pool, pool_scale, g_norm, w_out, norm_ffn_w, w_gate, w_up, w_down):
    xn = rmsnorm(x, norm_mix_w)
    p = xn @ w_in.astype(x.dtype)
    u = p[..., :POOL_W]
    off = POOL_W
    q = p[..., off:off + MLSTM_W]
    k = p[..., off + MLSTM_W:off + 2 * MLSTM_W]
    v = p[..., off + 2 * MLSTM_W:off + 3 * MLSTM_W]
    o = p[..., off + 3 * MLSTM_W:off + 4 * MLSTM_W]
    gi = p[..., off + 4 * MLSTM_W:off + 4 * MLSTM_W + N_HEADS]
    gf = p[..., off + 4 * MLSTM_W + N_HEADS:]
    y_pool, pool_new = pool_mix(pool_prev, u, pos0, w_pool, pool_scale)
    y_ml, C, n, m = mlstm_mixer(q, k, v, o, gi, gf, C0, n0, m0, segments, b_i, b_f, g_norm)
    x = x + jnp.concatenate([y_pool, y_ml], axis=-1) @ w_out.astype(x.dtype)
    xn2 = rmsnorm(x, norm_ffn_w)
    x = x + (jax.nn.silu(xn2 @ w_gate.astype(x.dtype)) * (xn2 @ w_up.astype(x.dtype))) @ w_down.astype(x.dtype)
    return x, pool_new, C, n, m


def setup_inputs(seed: int = 0) -> dict:
    key = jax.random.key(seed)
    ks = jax.random.split(key, 20)
    f32 = jnp.float32
    nrm = lambda k, s: jax.random.normal(k, s, dtype=f32)
    return {
        'x_prompt': nrm(ks[0], (BATCH, SEQ, D_MODEL)),
        'x_sample': nrm(ks[1], (DEC_BATCH, DEC_SEQ, D_MODEL)),
        'state_pool': nrm(ks[2], (DEPTH, DEC_BATCH, POOL_HIST, POOL_W)),
        'state_mlstm_C': nrm(ks[3], (DEPTH, DEC_BATCH, N_HEADS, HEAD_DIM, HEAD_DIM)) * HEAD_DIM ** -0.5,
        'state_mlstm_n': nrm(ks[4], (DEPTH, DEC_BATCH, N_HEADS, HEAD_DIM)) * HEAD_DIM ** -0.5,
        'state_mlstm_m': nrm(ks[5], (DEPTH, DEC_BATCH, N_HEADS)) * 0.5,
        'meta_tokens': nrm(ks[6], (N_META, D_MODEL)),
        'norm_mix_w': 1.0 + 0.02 * nrm(ks[7], (DEPTH, D_MODEL)),
        'w_in': nrm(ks[8], (DEPTH, D_MODEL, IN_W)) * D_MODEL ** -0.5,
        'b_igate': 0.1 * nrm(ks[9], (DEPTH, N_HEADS)),
        'b_fgate': jnp.linspace(3.0, 6.0, N_HEADS, dtype=f32)[None, :] + 0.01 * nrm(ks[10], (DEPTH, N_HEADS)),
        'w_pool': nrm(ks[11], (DEPTH, N_POOL_GROUPS, POOL_GW, POOL_GW)) * POOL_GW ** -0.5,
        'pool_scale': 1.0 + 0.1 * nrm(ks[12], (DEPTH, POOL_W)),
        'mlstm_norm_w': 1.0 + 0.02 * nrm(ks[13], (DEPTH, MLSTM_W)),
        'w_out': nrm(ks[14], (DEPTH, MIX_W, D_MODEL)) * MIX_W ** -0.5,
        'norm_ffn_w': 1.0 + 0.02 * nrm(ks[15], (DEPTH, D_MODEL)),
        'w_gate': nrm(ks[16], (DEPTH, D_MODEL, D_FF)) * D_MODEL ** -0.5,
        'w_up': nrm(ks[17], (DEPTH, D_MODEL, D_FF)) * D_MODEL ** -0.5,
        'w_down': nrm(ks[18], (DEPTH, D_FF, D_MODEL)) * D_FF ** -0.5,
        'norm_final_w': 1.0 + 0.02 * nrm(ks[19], (D_MODEL,)),
    }


def reference(x_prompt, x_sample, state_pool, state_mlstm_C, state_mlstm_n, state_mlstm_m, meta_tokens, norm_mix_w, w_in, b_igate, b_fgate, w_pool, pool_scale, mlstm_norm_w, w_out, norm_ffn_w, w_gate, w_up, w_down, norm_final_w):
    B, T_p, _ = x_prompt.shape
    T_s = x_sample.shape[1]
    dt = x_prompt.dtype
    hp = jnp.concatenate([jnp.broadcast_to(meta_tokens.astype(dt)[None], (B, N_META, D_MODEL)), x_prompt], axis=1)
    hs = x_sample
    seg_p = ((N_META, N_META), (T_p, CHUNK))
    seg_s = ((T_s, T_s),)
    pool_p, C_p, n_p, m_p = [], [], [], []
    pool_s, C_s, n_s, m_s = [], [], [], []
    for l in range(DEPTH):
        wl = (norm_mix_w[l], w_in[l], b_igate[l], b_fgate[l], w_pool[l], pool_scale[l], mlstm_norm_w[l], w_out[l], norm_ffn_w[l], w_gate[l], w_up[l], w_down[l])
        zp = jnp.zeros((B, POOL_HIST, POOL_W), dt)
        zC = jnp.zeros((B, N_HEADS, HEAD_DIM, HEAD_DIM), jnp.float32)
        zn = jnp.zeros((B, N_HEADS, HEAD_DIM), jnp.float32)
        zm = jnp.zeros((B, N_HEADS), jnp.float32)
        hp, sp, Cp, np_, mp = block(hp, zp, zC, zn, zm, 0, seg_p, *wl)
        hs, ss, Cs, ns, ms = block(hs, state_pool[l], state_mlstm_C[l], state_mlstm_n[l], state_mlstm_m[l], PAST_LEN, seg_s, *wl)
        pool_p.append(sp); C_p.append(Cp); n_p.append(np_); m_p.append(mp)
        pool_s.append(ss); C_s.append(Cs); n_s.append(ns); m_s.append(ms)
    y_prompt = rmsnorm(hp, norm_final_w)[:, N_META:]
    y_sample = rmsnorm(hs, norm_final_w)
    return (y_prompt, y_sample, jnp.stack(pool_p), jnp.stack(C_p), jnp.stack(n_p), jnp.stack(m_p), jnp.stack(pool_s), jnp.stack(C_s), jnp.stack(n_s), jnp.stack(m_s))
```

```cpp
#include <hip/hip_runtime.h>
#include <hip/hip_cooperative_groups.h>
#include <cstdio>
#include <cstdint>
namespace cg = cooperative_groups;
#ifndef ONE_LAUNCH
#define ONE_LAUNCH 1
#endif
namespace pg8 {
#define PG8_LAS __attribute__((address_space(3)))
typedef unsigned short bf16_t;
typedef short bf16x8 __attribute__((ext_vector_type(8)));
typedef float f32x4 __attribute__((ext_vector_type(4)));
typedef unsigned u32x4 __attribute__((ext_vector_type(4)));
constexpr int BM = 256, BK = 64, HALF = 128, HTB = HALF * BK * 2  , STAGE_BYTES = 8 * HTB, NXCD = 8, WGM = 8;

__host__ __device__ __forceinline__ int lds_byte(int r, int c) { const int st = (r >> 4) * 2 + (c >> 5), rr = r & 15, cc = c & 31, ob = rr * 64 + cc * 2; return st * 1024 + (ob ^ (((ob >> 9) & 1) << 5)); }
__host__ __device__ __forceinline__ void stage_rc(int b, int& R, int& C) { const int st = b / 1024, sb = b % 1024, swz = sb ^ (((sb >> 9) & 1) << 5); R = (st >> 1) * 16 + swz / 64; C = (st & 1) * 32 + (swz % 64) / 2; }
__host__ __device__ __forceinline__ int perm32(int rho) { const int n = rho >> 4, i = rho & 15; return 8 * (i >> 2) + 4 * n + (i & 3); }

struct Unit { int pm, pn, kt0, nt; };
struct Gemm { const bf16_t* A; const bf16_t* Bt; int M, N, K, lda, a_pn_bytes; };

struct StaticOrder {
    int nM, nN, nwg, G, c;
    __host__ __device__ void init(int M, int N, int G_, int c_) { nM = M / BM; nN = N / BM; nwg = nM * nN; G = G_; c = c_; }
    __host__ __device__ bool next(int i, Unit& u) const {
        const long L = (long)i * G + c; if (L >= nwg) return false;
        int wgid = (int)L; { const int q = nwg / NXCD, r = nwg % NXCD, xcd = wgid % NXCD, off = wgid / NXCD; wgid = (xcd < r ? xcd * (q + 1) : r * (q + 1) + (xcd - r) * q) + off; }
        const int nig = WGM * nN, gid = wgid / nig, fm = gid * WGM, gsz = (nM - fm) < WGM ? (nM - fm) : WGM;
        u.pm = fm + ((wgid % nig) % gsz); u.pn = (wgid % nig) / gsz; u.kt0 = 0; u.nt = 0; return true;
    }
    __device__ __forceinline__ void a_ready(const Unit&) const {}
    __device__ __forceinline__ void done(const Unit&) const {}
};

__device__ __forceinline__ unsigned cvt_pk_bf16(float lo, float hi) { unsigned r; asm volatile("v_cvt_pk_bf16_f32 %0, %1, %2" : "=v"(r) : "v"(lo), "v"(hi)); return r; }
typedef float f32x2 __attribute__((ext_vector_type(2)));
constexpr int kDM = 2048, kTP = 2064, kRP = 4 * 2064, kR = 9280, kMP = 9472;
struct RowMap { const float* xp; const float* xs; const float* meta; float* yp; float* ys; };
__device__ __forceinline__ const float* xrow_ptr(const RowMap& rm, int row) {
    if (row < kRP) { const int b = row / kTP, t = row - b * kTP; return t < 16 ? rm.meta + (size_t)t * kDM : rm.xp + ((size_t)b * 2048 + (t - 16)) * kDM; }
    return rm.xs + (size_t)(row - kRP) * kDM;
}
__device__ __forceinline__ float* yrow_ptr(const RowMap& rm, int row) {
    if (row < kRP) { const int b = row / kTP, t = row - b * kTP; return t < 16 ? nullptr : rm.yp + ((size_t)b * 2048 + (t - 16)) * kDM; }
    return rm.ys + (size_t)(row - kRP) * kDM;
}
typedef unsigned u32x2 __attribute__((ext_vector_type(2)));
struct EpiBf16 {
    static constexpr bool PERM = true, AFTER_DRAIN = false;
    __device__ __forceinline__ void prefetch_lds(const Unit&, PG8_LAS unsigned char*, int, int) const {}
    bf16_t* O; int ldc;
    __device__ __forceinline__ void operator()(const f32x4 (&acc)[2][2][4][2], const Unit& u, int wr, int wc, int fr, int fq, const PG8_LAS unsigned char* xl) const {
        const int row0 = u.pm * BM + wr * 64 + fr, col0 = u.pn * BM + wc * 32 + 8 * fq;
#pragma unroll
        for (int ai = 0; ai < 2; ++ai)
#pragma unroll
            for (int m = 0; m < 4; ++m) { bf16_t* rowp = O + (size_t)(row0 + ai * HALF + m * 16) * ldc + col0;
#pragma unroll
                for (int bj = 0; bj < 2; ++bj) { const f32x4 v0 = acc[ai][bj][m][0], v1 = acc[ai][bj][m][1];
                    u32x4 w; w.x = cvt_pk_bf16(v0[0], v0[1]); w.y = cvt_pk_bf16(v0[2], v0[3]); w.z = cvt_pk_bf16(v1[0], v1[1]); w.w = cvt_pk_bf16(v1[2], v1[3]);
                    *(u32x4*)(rowp + bj * HALF) = w; } }
    }
};
__device__ __forceinline__ float silu_mul(float g, float u) { return g * __builtin_amdgcn_rcpf(1.f + __expf(-g)) * u; }
struct EpiGU {
    static constexpr bool PERM = true, AFTER_DRAIN = false;
    __device__ __forceinline__ void prefetch_lds(const Unit& u, PG8_LAS unsigned char* xl, int wid, int lane) const {
        if (wid == 0) __builtin_amdgcn_global_load_lds((const unsigned*)(ss + u.pm * BM + 4 * lane), (PG8_LAS unsigned*)xl, 16, 0, 0); }
    bf16_t* H; int ldh; const float* ss; float eps;
    __device__ __forceinline__ void operator()(const f32x4 (&acc)[2][2][4][2], const Unit& u, int wr, int wc, int fr, int fq, const PG8_LAS unsigned char* xl) const {
        const int row0 = u.pm * BM + wr * 64 + fr, col0 = u.pn * HALF + wc * 32 + 8 * fq;
#pragma unroll
        for (int ai = 0; ai < 2; ++ai)
#pragma unroll
            for (int m = 0; m < 4; ++m) { const int row = row0 + ai * HALF + m * 16; const float rs = 1.0f / sqrtf(*(const PG8_LAS float*)(xl + 4 * (row - u.pm * BM)) * (1.0f / 2048.0f) + eps);
                const f32x4 g0 = acc[ai][0][m][0] * rs, g1 = acc[ai][0][m][1] * rs, u0 = acc[ai][1][m][0] * rs, u1 = acc[ai][1][m][1] * rs;
                u32x4 w; w.x = cvt_pk_bf16(silu_mul(g0[0], u0[0]), silu_mul(g0[1], u0[1])); w.y = cvt_pk_bf16(silu_mul(g0[2], u0[2]), silu_mul(g0[3], u0[3]));
                w.z = cvt_pk_bf16(silu_mul(g1[0], u1[0]), silu_mul(g1[1], u1[1])); w.w = cvt_pk_bf16(silu_mul(g1[2], u1[2]), silu_mul(g1[3], u1[3]));
                *(u32x4*)(H + (size_t)row * ldh + col0) = w; }
    }
};
struct EpiOut {
    static constexpr bool PERM = false, AFTER_DRAIN = false;
    __device__ __forceinline__ void prefetch_lds(const Unit&, PG8_LAS unsigned char*, int, int) const {}
    float* X1; bf16_t* X1B; float* ss; RowMap rm;
    __device__ __forceinline__ void operator()(const f32x4 (&acc)[2][2][4][2], const Unit& u, int wr, int wc, int fr, int fq, const PG8_LAS unsigned char* xl) const {
        const int col0 = u.pn * BM + wc * 32 + 4 * fq;
#pragma unroll
        for (int ai = 0; ai < 2; ++ai)
#pragma unroll
            for (int m = 0; m < 4; ++m) { const int row = u.pm * BM + ai * HALF + wr * 64 + m * 16 + fr;
                if (row < kR) { const float* xr = xrow_ptr(rm, row); float s = 0.f;
#pragma unroll
                    for (int bj = 0; bj < 2; ++bj)
#pragma unroll
                        for (int n = 0; n < 2; ++n) { const int c = col0 + bj * HALF + n * 16; const f32x4 v = *(const f32x4*)(xr + c) + acc[ai][bj][m][n];
                            *(f32x4*)(X1 + (size_t)row * kDM + c) = v; u32x2 w; w.x = cvt_pk_bf16(v[0], v[1]); w.y = cvt_pk_bf16(v[2], v[3]);
                            *(u32x2*)(X1B + (size_t)row * kDM + c) = w; s += (v[0] * v[0] + v[1] * v[1]) + (v[2] * v[2] + v[3] * v[3]); }
                    s += __shfl_xor(s, 16); s += __shfl_xor(s, 32);
                    if (fq == 0) atomicAdd(ss + row, s); } }
    }
};
struct EpiDown {
    static constexpr bool PERM = false, AFTER_DRAIN = false;
    __device__ __forceinline__ void prefetch_lds(const Unit&, PG8_LAS unsigned char*, int, int) const {}
    const float* X1; float* slab; RowMap rm;
    __device__ __forceinline__ void operator()(const f32x4 (&acc)[2][2][4][2], const Unit& u, int wr, int wc, int fr, int fq, const PG8_LAS unsigned char* xl) const {
        const int col0 = u.pn * BM + wc * 32 + 4 * fq;
        if (u.nt == 22) { float* sl = slab + (size_t)(u.kt0 / 22) * (1280 * kDM);
#pragma unroll
            for (int ai = 0; ai < 2; ++ai)
#pragma unroll
                for (int m = 0; m < 4; ++m) { const int row = u.pm * BM + ai * HALF + wr * 64 + m * 16 + fr;
                    if (row < kR) {
#pragma unroll
                        for (int bj = 0; bj < 2; ++bj)
#pragma unroll
                            for (int n = 0; n < 2; ++n) *(f32x4*)(sl + (size_t)(row - 8192) * kDM + col0 + bj * HALF + n * 16) = acc[ai][bj][m][n]; } }
            return; }
#pragma unroll
        for (int ai = 0; ai < 2; ++ai)
#pragma unroll
            for (int m = 0; m < 4; ++m) { const int row = u.pm * BM + ai * HALF + wr * 64 + m * 16 + fr;
                if (row < kR) { float* yr = yrow_ptr(rm, row);
                    if (yr) {
#pragma unroll
                    for (int bj = 0; bj < 2; ++bj)
#pragma unroll
                        for (int n = 0; n < 2; ++n) { const int c = col0 + bj * HALF + n * 16; *(f32x4*)(yr + c) = *(const f32x4*)(X1 + (size_t)row * kDM + c) + acc[ai][bj][m][n]; } } } }
    }
};
struct OutOrder {
    int c, mode;
    __device__ __forceinline__ bool next(int i, Unit& u) const {
        if (i != 0) return false;
        u.kt0 = 0; u.nt = 0;
        if (mode == 0) { const int xcd = c & 7, slot = c >> 3, L = xcd * 32 + slot; u.pm = (L >> 6) * 8 + (L & 7); u.pn = (L >> 3) & 7; return true; }
        if (c < 40) { u.pm = 32 + (c >> 3); u.pn = c & 7; return true; }
        return false;
    }
    __device__ __forceinline__ void a_ready(const Unit&) const {}
    __device__ __forceinline__ void done(const Unit&) const {}
};
struct GuOrder {
    int c, mode;
    static __device__ __forceinline__ void decode(int N, Unit& u) { u.kt0 = 0; u.nt = 0; if (N < 1408) { const int g = N / 352, r = N - g * 352; u.pn = r >> 3; u.pm = 8 * g + (r & 7); } else { const int r = N - 1408; u.pn = r / 5; u.pm = 32 + (r - 5 * u.pn); } }
    __device__ __forceinline__ bool next(int i, Unit& u) const {
        if (mode == 0) { if (i == 0 && c >= 40 && c < 132) { decode(c - 40, u); return true; } return false; }
        if (i < 6) { const int xcd = c & 7, slot = c >> 3; decode(92 + i * 256 + xcd * 32 + slot, u); return true; }
        return false;
    }
    __device__ __forceinline__ void a_ready(const Unit&) const {}
    __device__ __forceinline__ void done(const Unit&) const {}
};
struct FoldOrder {
    int c;
    __device__ __forceinline__ bool next(int i, Unit& u) const { const int j = c + 28 * i; if (c < 0 || i > 1 || j >= 32) return false; u.pm = j >> 2; u.pn = j & 3; u.kt0 = 0; u.nt = 0; return true; }
    __device__ __forceinline__ void a_ready(const Unit&) const {}
    __device__ __forceinline__ void done(const Unit&) const {}
};
struct DownOrder {
    int c;
    __device__ __forceinline__ bool next(int i, Unit& u) const {
        if (i == 0) { const int xcd = c & 7, slot = c >> 3; const int L = xcd * 32 + slot; u.pm = (L >> 6) * 8 + (L & 7); u.pn = (L >> 3) & 7; u.kt0 = 0; u.nt = 0; return true; }
        if (i == 1 && c < 160) { const int q = c >> 2; u.pm = 32 + (q >> 3); u.pn = q & 7; u.kt0 = 22 * (c & 3); u.nt = 22; return true; }
        return false;
    }
    __device__ __forceinline__ void a_ready(const Unit&) const {}
    __device__ __forceinline__ void done(const Unit&) const {}
};
template <class Epi, class Sched, bool ALIGN_EPI = false, bool SP2 = false>
__device__ __forceinline__ void gemm_phase(PG8_LAS unsigned char* lds, const Gemm g, const Sched& S, const Epi& E) {
    const int tid = threadIdx.x, wid = __builtin_amdgcn_readfirstlane(tid >> 6), lane = tid & 63, wr = wid >> 2, wc = wid & 3, fr = lane & 15, fq = lane >> 4;
    const int K = g.K, nt = K / BK;
    unsigned voffA[2], voffB[2];
#pragma unroll
    for (int i = 0; i < 2; ++i) { int R, C; stage_rc(tid * 16 + i * 8192, R, C); const int Rb = Epi::PERM ? ((R & ~31) + perm32(R & 31)) : R;
        voffA[i] = (unsigned)(R * g.lda + C) * 2u; voffB[i] = (unsigned)(Rb * K + C) * 2u; }
    const size_t kstep = (size_t)(BK * 2);
    const size_t hstepA = (size_t)HALF * g.lda * 2, hstepB = (size_t)HALF * K * 2;
    const size_t tstepA = 2 * hstepA, tstepB = 2 * hstepB;
    const unsigned ldsw = (unsigned)wid * 1024u;
    const int aoff = lds_byte(wr * 64 + fr, fq * 8), boff = lds_byte(wc * 32 + fr, fq * 8);
#define PG8_SA(b, h) (((b) * 2 + (h)) * HTB)
#define PG8_SB(b, h) ((4 + (b) * 2 + (h)) * HTB)
#define PG8_STAGE(bufoff, gbase, voff) do { _Pragma("unroll") for (int _i = 0; _i < 2; ++_i) \
        __builtin_amdgcn_global_load_lds((const unsigned*)((const char*)(gbase) + (voff)[_i]), (PG8_LAS unsigned*)(lds + (bufoff) + ldsw + _i * 8192), 16, 0, 0); } while (0)
#define PG8_LDA(dst, b, h) do { _Pragma("unroll") for (int m = 0; m < 4; ++m) _Pragma("unroll") for (int k = 0; k < 2; ++k) dst[m][k] = *(const PG8_LAS bf16x8*)(lds + PG8_SA(b, h) + aoff + m * 2048 + k * 1024); } while (0)
#define PG8_LDB(dst, b, h) do { _Pragma("unroll") for (int n = 0; n < 2; ++n) _Pragma("unroll") for (int k = 0; k < 2; ++k) dst[n][k] = *(const PG8_LAS bf16x8*)(lds + PG8_SB(b, h) + boff + n * 2048 + k * 1024); } while (0)
#define PG8_MMA(ai, bj, At, Bt) do { __builtin_amdgcn_s_setprio(1); _Pragma("unroll") for (int m = 0; m < 4; ++m) _Pragma("unroll") for (int n = 0; n < 2; ++n) _Pragma("unroll") for (int k = 0; k < 2; ++k) \
        acc[ai][bj][m][n] = __builtin_amdgcn_mfma_f32_16x16x32_bf16(Bt[n][k], At[m][k], acc[ai][bj][m][n], 0, 0, 0); __builtin_amdgcn_s_setprio(0); } while (0)
#define PG8_WAIT_V(n) asm volatile("s_waitcnt vmcnt(" #n ")" ::: "memory")
#define PG8_WAIT_L(n) asm volatile("s_waitcnt lgkmcnt(" #n ")" ::: "memory")
#define PG8_BAR __builtin_amdgcn_s_barrier()
#define PG8_SCHED __builtin_amdgcn_sched_barrier(0)
    Unit cur, nxt; int ui = 0;
    if (!S.next(0, cur)) return;
    f32x4 acc[2][2][4][2];
#pragma unroll
    for (int a = 0; a < 2; ++a)
#pragma unroll
        for (int b = 0; b < 2; ++b)
#pragma unroll
            for (int m = 0; m < 4; ++m)
#pragma unroll
                for (int n = 0; n < 2; ++n) acc[a][b][m][n] = (f32x4){0.f, 0.f, 0.f, 0.f};
    bf16x8 At[4][2], B0[2][2], B1[2][2];
    const char* cA = (const char*)g.A + (size_t)cur.pm * tstepA + (size_t)cur.pn * g.a_pn_bytes + (size_t)cur.kt0 * kstep; const char* cB = (const char*)g.Bt + (size_t)cur.pn * tstepB + (size_t)cur.kt0 * kstep;
    S.a_ready(cur);
    if constexpr (SP2) {
        PG8_STAGE(PG8_SB(0, 0), cB, voffB); PG8_STAGE(PG8_SB(0, 1), cB + hstepB, voffB); PG8_STAGE(PG8_SA(0, 0), cA, voffA); PG8_STAGE(PG8_SA(0, 1), cA + hstepA, voffA);
        if (wr == 1) PG8_BAR;
        PG8_WAIT_V(2); PG8_BAR;
        PG8_STAGE(PG8_SB(1, 0), cB + kstep, voffB); PG8_STAGE(PG8_SA(1, 0), cA + kstep, voffA); PG8_STAGE(PG8_SB(1, 1), cB + hstepB + kstep, voffB);
        PG8_WAIT_V(6); PG8_BAR;
    } else {
        PG8_STAGE(PG8_SB(0, 0), cB, voffB); PG8_STAGE(PG8_SA(0, 0), cA, voffA); PG8_STAGE(PG8_SB(0, 1), cB + hstepB, voffB); PG8_STAGE(PG8_SA(0, 1), cA + hstepA, voffA);
        if (wr == 1) PG8_BAR;
        PG8_WAIT_V(4); PG8_BAR;
        PG8_STAGE(PG8_SB(1, 0), cB + kstep, voffB); PG8_STAGE(PG8_SA(1, 0), cA + kstep, voffA); PG8_STAGE(PG8_SB(1, 1), cB + hstepB + kstep, voffB);
        PG8_WAIT_V(6); PG8_BAR;
    }
    for (;;) {
        const bool has_next = S.next(ui + 1, nxt);
        const char* nA = has_next ? (const char*)g.A + (size_t)nxt.pm * tstepA + (size_t)nxt.pn * g.a_pn_bytes + (size_t)nxt.kt0 * kstep : cA; const char* nB = has_next ? (const char*)g.Bt + (size_t)nxt.pn * tstepB + (size_t)nxt.kt0 * kstep : cB;
        const int ntu = cur.nt ? cur.nt : nt;
        for (int t = 0; t < ntu; t += 2) {
            const bool last = (t == ntu - 2);
            const char* a1 = cA + (size_t)(t + 1) * kstep;
            const char* a2 = last ? nA : cA + (size_t)(t + 2) * kstep; const char* b2 = last ? nB : cB + (size_t)(t + 2) * kstep;
            const char* a3 = a2 + kstep; const char* b3 = b2 + kstep;
            if (last && has_next) S.a_ready(nxt);
            if (last) E.prefetch_lds(cur, lds + STAGE_BYTES, wid, lane);
            if constexpr (SP2) {
            PG8_LDB(B0, 0, 0); PG8_LDB(B1, 0, 1); PG8_SCHED; PG8_LDA(At, 0, 0); PG8_STAGE(PG8_SA(1, 1), a1 + hstepA, voffA);
            PG8_WAIT_V(8); PG8_WAIT_L(0); PG8_BAR; PG8_MMA(0, 0, At, B0); PG8_MMA(0, 1, At, B1); PG8_BAR; PG8_SCHED;
            PG8_LDA(At, 0, 1); PG8_STAGE(PG8_SB(0, 0), b2, voffB); PG8_STAGE(PG8_SB(0, 1), b2 + hstepB, voffB); PG8_STAGE(PG8_SA(0, 0), a2, voffA);
            PG8_WAIT_V(8); PG8_WAIT_L(0); PG8_BAR; PG8_MMA(1, 0, At, B0); PG8_MMA(1, 1, At, B1); PG8_BAR; PG8_SCHED;
            PG8_LDB(B0, 1, 0); PG8_LDB(B1, 1, 1); PG8_SCHED; PG8_LDA(At, 1, 0); PG8_STAGE(PG8_SA(0, 1), a2 + hstepA, voffA);
            PG8_WAIT_V(8); PG8_WAIT_L(0); PG8_BAR; PG8_MMA(0, 0, At, B0); PG8_MMA(0, 1, At, B1); PG8_BAR; PG8_SCHED;
            PG8_LDA(At, 1, 1); PG8_STAGE(PG8_SB(1, 0), b3, voffB); PG8_STAGE(PG8_SB(1, 1), b3 + hstepB, voffB); PG8_STAGE(PG8_SA(1, 0), a3, voffA);
            PG8_WAIT_V(8); PG8_WAIT_L(0); PG8_BAR; PG8_MMA(1, 0, At, B0); PG8_MMA(1, 1, At, B1); PG8_BAR; PG8_SCHED;
            } else {
            PG8_LDB(B0, 0, 0); PG8_SCHED; PG8_LDA(At, 0, 0); PG8_STAGE(PG8_SA(1, 1), a1 + hstepA, voffA);
            PG8_WAIT_L(8); PG8_BAR; PG8_WAIT_L(0); PG8_MMA(0, 0, At, B0); PG8_BAR; PG8_SCHED;
            PG8_LDB(B1, 0, 1); PG8_STAGE(PG8_SB(0, 0), b2, voffB);
            PG8_BAR; PG8_WAIT_L(0); PG8_MMA(0, 1, At, B1); PG8_BAR;
            PG8_LDA(At, 0, 1); PG8_STAGE(PG8_SA(0, 0), a2, voffA);
            PG8_BAR; PG8_WAIT_L(0); PG8_MMA(1, 0, At, B0); PG8_BAR; PG8_SCHED;
            PG8_STAGE(PG8_SB(0, 1), b2 + hstepB, voffB);
            PG8_WAIT_V(6); PG8_BAR; PG8_MMA(1, 1, At, B1); PG8_BAR;
            PG8_LDB(B0, 1, 0); PG8_SCHED; PG8_LDA(At, 1, 0); PG8_STAGE(PG8_SA(0, 1), a2 + hstepA, voffA);
            PG8_WAIT_L(8); PG8_BAR; PG8_WAIT_L(0); PG8_MMA(0, 0, At, B0); PG8_BAR; PG8_SCHED;
            PG8_LDB(B1, 1, 1); PG8_STAGE(PG8_SB(1, 0), b3, voffB);
            PG8_BAR; PG8_WAIT_L(0); PG8_MMA(0, 1, At, B1); PG8_BAR;
            PG8_LDA(At, 1, 1); PG8_STAGE(PG8_SA(1, 0), a3, voffA);
            PG8_BAR; PG8_WAIT_L(0); PG8_MMA(1, 0, At, B0); PG8_BAR; PG8_SCHED;
            PG8_STAGE(PG8_SB(1, 1), b3 + hstepB, voffB);
            PG8_WAIT_V(6); PG8_BAR; PG8_MMA(1, 1, At, B1); PG8_BAR;
            }
        }
        if constexpr (ALIGN_EPI) { if (wr == 0) PG8_BAR; }
        if constexpr (!Epi::AFTER_DRAIN) { E(acc, cur, wr, wc, fr, fq, lds + STAGE_BYTES); S.done(cur); }
        if (!has_next) break;
#pragma unroll
        for (int a = 0; a < 2; ++a)
#pragma unroll
            for (int b = 0; b < 2; ++b)
#pragma unroll
                for (int m = 0; m < 4; ++m)
#pragma unroll
                    for (int n = 0; n < 2; ++n) acc[a][b][m][n] = (f32x4){0.f, 0.f, 0.f, 0.f};
        cur = nxt; cA = nA; cB = nB; ++ui;
        if constexpr (ALIGN_EPI) { if (wr == 1) PG8_BAR; }
    }
    PG8_WAIT_V(0);
    if constexpr (!ALIGN_EPI) { if (wr == 0) PG8_BAR; }
    PG8_BAR;
#undef PG8_SA
#undef PG8_SB
#undef PG8_STAGE
#undef PG8_LDA
#undef PG8_LDB
#undef PG8_MMA
#undef PG8_WAIT_V
#undef PG8_WAIT_L
#undef PG8_BAR
#undef PG8_SCHED
}
}
#define LAS __attribute__((address_space(3)))
typedef unsigned short bf16;
typedef float f32x4 __attribute__((ext_vector_type(4)));
typedef unsigned v4u __attribute__((ext_vector_type(4)));
typedef unsigned v2u __attribute__((ext_vector_type(2)));
typedef short bf16x8 __attribute__((ext_vector_type(8)));
constexpr int NWAVES = 8, NTHR = 512;
constexpr int DM = 2048, TP = 2064, RP = 8256, RS = 1024, R = 9280, MP = 9472, INW = 5128, PW = 5120, DFF = 5632, NCH = 33;
constexpr float EPS = 1e-6f;
constexpr int LDS_BYTES = 147456;
constexpr size_t MiB = 1u << 20;
constexpr size_t WS_WIN = 0;
constexpr size_t WS_WOUT = 20 * MiB;
constexpr size_t WS_WGU = 28 * MiB;
constexpr size_t WS_WD = 72 * MiB;
constexpr size_t WS_WP = 94 * MiB;
constexpr size_t WS_GATES = 95 * MiB;
constexpr size_t WS_SS1 = 96 * MiB;
constexpr size_t WS_SS2 = 96 * MiB + 65536;
constexpr size_t WS_NST = 232 * MiB;
constexpr size_t WS_MST = 98 * MiB;
constexpr size_t WS_CTL = 99 * MiB, CTL_BYTES = 65536;
constexpr size_t WS_XN = 100 * MiB;
constexpr size_t WS_P = 138 * MiB;
constexpr size_t WS_D = 232 * MiB;
constexpr size_t WS_H = 406 * MiB;
constexpr size_t WS_MIX = 252 * MiB;
constexpr size_t WS_X1 = 290 * MiB;
constexpr size_t WS_CT = WS_X1;
constexpr size_t WS_SLAB = 366 * MiB;
constexpr size_t WS_END = 508 * MiB;
static_assert(WS_H + (size_t)MP * DFF * 2 <= WS_END && WS_SLAB + (size_t)4 * 1280 * DM * 4 <= WS_H && WS_P + (size_t)MP * PW * 2 <= WS_D && WS_D + (size_t)MP * 1024 * 2 <= WS_MIX && WS_MIX + (size_t)MP * DM * 2 <= WS_X1 && WS_X1 + (size_t)MP * DM * 4 <= WS_END, "ws map");
constexpr size_t O_YP = 0, O_YS = 16777216, O_POOLP = 18874368, O_CP = 18935808, O_NP = 19984384, O_MP = 19988480, O_POOLS = 19988496, O_CS = 21954576, O_NS = 55509008, O_MS = 55640080, O_END = 55640592;

#define LDS_WAIT() asm volatile("s_waitcnt lgkmcnt(0)" ::: "memory")
#define LBAR() do { asm volatile("s_waitcnt lgkmcnt(0)" ::: "memory"); __builtin_amdgcn_s_barrier(); asm volatile("" ::: "memory"); } while (0)
__device__ __forceinline__ unsigned f2bf(float f) { unsigned u = __builtin_bit_cast(unsigned, f); return (u + 0x7fffu + ((u >> 16) & 1u)) >> 16; }
__device__ __forceinline__ unsigned pk2(float lo, float hi) { return pg8::cvt_pk_bf16(lo, hi); }
__device__ __forceinline__ float bf2f(unsigned short b) { return __builtin_bit_cast(float, (unsigned)b << 16); }
__device__ __forceinline__ float bflo(unsigned w) { return __builtin_bit_cast(float, w << 16); }
__device__ __forceinline__ float bfhi(unsigned w) { return __builtin_bit_cast(float, w & 0xffff0000u); }
template <int CTRL, int ROWMASK> __device__ __forceinline__ float dpp_f(float oldv, float v) {
    return __builtin_bit_cast(float, __builtin_amdgcn_update_dpp(__builtin_bit_cast(int, oldv), __builtin_bit_cast(int, v), CTRL, ROWMASK, 0xf, false));
}
__device__ __forceinline__ float scan_add_dpp(float v) {
    v += dpp_f<0x111, 0xf>(0.f, v); v += dpp_f<0x112, 0xf>(0.f, v); v += dpp_f<0x114, 0xf>(0.f, v); v += dpp_f<0x118, 0xf>(0.f, v);
    v += dpp_f<0x142, 0xa>(0.f, v);
    v += dpp_f<0x143, 0xc>(0.f, v);
    return v;
}
__device__ __forceinline__ float scan_max_dpp(float v) {
    const float ni = -INFINITY;
    v = fmaxf(v, dpp_f<0x111, 0xf>(ni, v)); v = fmaxf(v, dpp_f<0x112, 0xf>(ni, v)); v = fmaxf(v, dpp_f<0x114, 0xf>(ni, v)); v = fmaxf(v, dpp_f<0x118, 0xf>(ni, v));
    v = fmaxf(v, dpp_f<0x142, 0xa>(ni, v));
    v = fmaxf(v, dpp_f<0x143, 0xc>(ni, v));
    return v;
}
__device__ __forceinline__ float row16_sum_dpp(float v) {
    v += dpp_f<0x111, 0xf>(0.f, v); v += dpp_f<0x112, 0xf>(0.f, v); v += dpp_f<0x114, 0xf>(0.f, v); v += dpp_f<0x118, 0xf>(0.f, v); return v; }
__device__ __forceinline__ float row8_sum_dpp(float v) {
    v += dpp_f<0x111, 0xf>(0.f, v); v += dpp_f<0x112, 0xf>(0.f, v); v += dpp_f<0x114, 0xf>(0.f, v); return v; }
__device__ __forceinline__ float lane63(float v) { return __builtin_bit_cast(float, __builtin_amdgcn_readlane(__builtin_bit_cast(int, v), 63)); }
__device__ __forceinline__ float wave_sum(float v) { return lane63(scan_add_dpp(v)); }
__device__ __forceinline__ float logsigmoid(float x) { return x >= 0.f ? -log1pf(expf(-x)) : x - log1pf(expf(x)); }
__device__ __forceinline__ float sigmoidf(float x) { return __builtin_amdgcn_rcpf(1.0f + __expf(-x)); }

struct Ptrs;
typedef const __attribute__((address_space(4))) Ptrs* KP;
struct Ptrs {
    const float *xp, *xs, *spool, *sC, *sn, *sm, *meta, *nmix, *win, *bi, *bf, *wpool, *pscale, *gnorm, *wout, *nffn, *wgate, *wup, *wdown, *nfinal;
    float* out; unsigned char* ws;
};

#define XB_TMO      128
#define XB_XCNT(j)  (256  + 64 * (j))
#define XB_XSUB(j)  (1280 + 64 * (j))
#define XB_XGEN(j)  (2304 + 64 * (j))
#define XB_TOP      3328
#define XB_TOPGEN   3392
#define XCD_BAR_WORDS 3456
#define XB_SPIN_CAP (1u << 18)

__device__ __forceinline__ unsigned xb_ld(unsigned* p)              { return __hip_atomic_load(p, __ATOMIC_RELAXED, __HIP_MEMORY_SCOPE_AGENT); }
__device__ __forceinline__ unsigned xb_add(unsigned* p, unsigned v) { return __hip_atomic_fetch_add(p, v, __ATOMIC_RELAXED, __HIP_MEMORY_SCOPE_AGENT); }
__device__ __forceinline__ unsigned xb_xcc_id() { return (unsigned)__builtin_amdgcn_s_getreg((3 << 11) | 20) & 0xFu; }
#define XB_SPIN(cond, bar) do { unsigned _sp = 0; while (cond) { __builtin_amdgcn_s_sleep(1); \
    if ((++_sp & 255u) == 0u) { if (xb_ld(&(bar)[XB_TMO])) break; if (_sp > XB_SPIN_CAP) { atomicAdd(&(bar)[XB_TMO], 1u); break; } } } } while (0)

struct XcdBarrier {
    unsigned* bar; unsigned x;
    volatile LAS unsigned* st;
};

__device__ __forceinline__ XcdBarrier xcd_barrier_post(unsigned* bar, volatile LAS unsigned* st) {
    XcdBarrier b; b.bar = bar; b.x = xb_xcc_id(); b.st = st;
    if (threadIdx.x == 0) (void)xb_add(&bar[XB_XCNT(b.x)], 1u);
    return b;
}
__device__ __forceinline__ void xcd_barrier_complete(unsigned* bar, unsigned x, unsigned& nloc, unsigned& nx) {
    const unsigned G = gridDim.x * gridDim.y * gridDim.z;
    unsigned sum, cnt, mine, sp = 0u;
    for (;;) {
        sum = 0u; cnt = 0u; mine = 0u;
#pragma unroll
        for (unsigned j = 0; j < 16; ++j) { const unsigned c = xb_ld(&bar[XB_XCNT(j)]); sum += c; cnt += (c > 0u) ? 1u : 0u; mine = (j == x) ? c : mine; }
        if (sum == G) break;
        __builtin_amdgcn_s_sleep(1);
        if ((++sp & 255u) == 0u) { if (xb_ld(&bar[XB_TMO])) break; if (sp > XB_SPIN_CAP) { atomicAdd(&bar[XB_TMO], 1u); break; } }
    }
    nloc = mine > 0u ? mine : 1u; nx = cnt > 0u ? cnt : 1u;
}

__device__ __forceinline__ void xcd_barrier(const XcdBarrier& b) {
    asm volatile("s_waitcnt vmcnt(0)" ::: "memory");
    __syncthreads();
    if (threadIdx.x == 0) {
        unsigned* bar = b.bar;
        __builtin_amdgcn_s_waitcnt(0);
        unsigned nloc = b.st[0], nx = b.st[1];
        if (nloc == 0u) { xcd_barrier_complete(bar, b.x, nloc, nx); b.st[0] = nloc; b.st[1] = nx; }
        const unsigned old = xb_add(&bar[XB_XSUB(b.x)], 1u);
        const unsigned gen = old / nloc;
        if (old + 1u == (gen + 1u) * nloc) {
            __builtin_amdgcn_fence(__ATOMIC_RELEASE, "agent");
            asm volatile("s_waitcnt vmcnt(0)" ::: "memory");
            const unsigned og = xb_add(&bar[XB_TOP], 1u);
            const unsigned tg = og / nx;
            if (og + 1u == (tg + 1u) * nx) xb_add(&bar[XB_TOPGEN], 1u);
            else XB_SPIN(xb_ld(&bar[XB_TOPGEN]) == tg, bar);
            __builtin_amdgcn_fence(__ATOMIC_ACQUIRE, "agent");
            xb_add(&bar[XB_XGEN(b.x)], 1u);
            asm volatile("s_waitcnt vmcnt(0)" ::: "memory");
        } else {
            XB_SPIN(xb_ld(&bar[XB_XGEN(b.x)]) == gen, bar);
            __builtin_amdgcn_fence(__ATOMIC_ACQUIRE, "agent");
            asm volatile("s_waitcnt vmcnt(0)" ::: "memory");
        }
    }
    __syncthreads();
}

__device__ __forceinline__ void transpose_item(const float* W, int ldw, bf16* WT, int ldt, int k0, int n0, int drow0, const float* kscale, const float* nscale, LAS float* scr, int lane) {
    const float ns = nscale ? nscale[n0 + lane] : 1.f;
    const float* src = W + (size_t)k0 * ldw + n0 + lane;
    float v[64];
#pragma unroll
    for (int i = 0; i < 64; ++i) v[i] = __builtin_nontemporal_load(src + (size_t)i * ldw);
#pragma unroll
    for (int i = 0; i < 64; ++i) { float x = v[i]; if (kscale) x *= kscale[k0 + i]; scr[i * 65 + lane] = x * ns; }
    LDS_WAIT(); asm volatile("" ::: "memory");
    const int c = lane & 7;
#pragma unroll
    for (int j = 0; j < 8; ++j) { const int n = (lane >> 3) + 8 * j; const LAS float* s = scr + (8 * c) * 65 + n;
        v4u o; o.x = pk2(s[0 * 65], s[1 * 65]); o.y = pk2(s[2 * 65], s[3 * 65]); o.z = pk2(s[4 * 65], s[5 * 65]); o.w = pk2(s[6 * 65], s[7 * 65]);
        *(v4u*)(WT + (size_t)(drow0 + n) * ldt + k0 + 8 * c) = o; }
    LDS_WAIT(); asm volatile("" ::: "memory");
}
__device__ __forceinline__ void p0_prologue(KP p, LAS unsigned char* lds, int tid, int lane, int wave, int G, int part = 3) {
    unsigned char* ws = p->ws;
    bf16* Win_t = (bf16*)(ws + WS_WIN); bf16* Wout_t = (bf16*)(ws + WS_WOUT); bf16* Wgu_t = (bf16*)(ws + WS_WGU); bf16* Wd_t = (bf16*)(ws + WS_WD); bf16* Wp_t = (bf16*)(ws + WS_WP);
    float* GATES = (float*)(ws + WS_GATES); bf16* XN = (bf16*)(ws + WS_XN);
    const int gw = blockIdx.x * NWAVES + wave, NGW = G * NWAVES;
    for (int i = blockIdx.x * NTHR + tid; i < 2 * 16384; i += G * NTHR) ((float*)(ws + WS_SS1))[i] = 0.f;
    LAS float* GW = (LAS float*)lds;
    for (int k = tid; k < DM; k += NTHR) { const f32x4 a = *(const f32x4*)(p->win + (size_t)k * INW + 5120), b = *(const f32x4*)(p->win + (size_t)k * INW + 5124);
        GW[0 * DM + k] = a[0]; GW[1 * DM + k] = a[1]; GW[2 * DM + k] = a[2]; GW[3 * DM + k] = a[3]; GW[4 * DM + k] = b[0]; GW[5 * DM + k] = b[1]; GW[6 * DM + k] = b[2]; GW[7 * DM + k] = b[3]; }
    __syncthreads();
    pg8::RowMap rm{p->xp, p->xs, p->meta, nullptr, nullptr};
    f32x4 vn[8];
    if (gw < R) { const f32x4* xr = (const f32x4*)pg8::xrow_ptr(rm, gw) + lane;
#pragma unroll
        for (int j = 0; j < 8; ++j) vn[j] = xr[64 * j]; }
    if (part & 1) for (int r = gw; r < MP; r += NGW) {
        unsigned long long* o8 = (unsigned long long*)(XN + (size_t)r * DM) + lane;
        if (r >= R) {
#pragma unroll
            for (int j = 0; j < 8; ++j) o8[64 * j] = 0ull;
            continue; }
        f32x4 v[8]; float s = 0.f;
#pragma unroll
        for (int j = 0; j < 8; ++j) { v[j] = vn[j]; s += (v[j][0] * v[j][0] + v[j][1] * v[j][1]) + (v[j][2] * v[j][2] + v[j][3] * v[j][3]); }
        if (r + NGW < R) { const f32x4* xr = (const f32x4*)pg8::xrow_ptr(rm, r + NGW) + lane;
#pragma unroll
            for (int j = 0; j < 8; ++j) vn[j] = xr[64 * j]; }
        const float rstd = 1.0f / sqrtf(wave_sum(s) * (1.0f / DM) + EPS);
        float ga[8];
#pragma unroll
        for (int g = 0; g < 8; ++g) ga[g] = 0.f;
#pragma unroll
        for (int j = 0; j < 8; ++j) { const f32x4 w4 = ((const f32x4*)p->nmix)[64 * j + lane]; const f32x4 y = v[j] * rstd * w4;
            o8[64 * j] = (unsigned long long)pk2(y[0], y[1]) | ((unsigned long long)pk2(y[2], y[3]) << 32);
#pragma unroll
            for (int g = 0; g < 8; ++g) { const f32x4 gw4 = *(const LAS f32x4*)(GW + g * DM + (64 * j + lane) * 4); ga[g] += (y[0] * gw4[0] + y[1] * gw4[1]) + (y[2] * gw4[2] + y[3] * gw4[3]); } }
#pragma unroll
        for (int g = 0; g < 8; ++g) ga[g] = wave_sum(ga[g]);
        if (lane == 0) { *(f32x4*)(GATES + (size_t)r * 8) = (f32x4){ga[0], ga[1], ga[2], ga[3]}; *(f32x4*)(GATES + (size_t)r * 8 + 4) = (f32x4){ga[4], ga[5], ga[6], ga[7]}; }
    }
    __syncthreads();
    LAS float* scr = (LAS float*)(lds + wave * 16640);
    constexpr int I_IN = 32 * 80, I_OUT = 32 * 32, I_G = 32 * 88, I_D = 88 * 32, I_P = 4 * 16;
    constexpr int NITEMS = I_IN + I_OUT + 2 * I_G + I_D; (void)I_P;
    if (part & 2) for (int it = gw; it < NITEMS; it += NGW) {
        int r = it;
        if (r < I_IN) { const int kb = r / 80, nb = r % 80; transpose_item(p->win, INW, Win_t, DM, 64 * kb, 64 * nb, 64 * nb, nullptr, nullptr, scr, lane); continue; } r -= I_IN;
        if (r < I_OUT) { const int kb = r / 32, nb = r % 32; transpose_item(p->wout, DM, Wout_t, DM, 64 * kb, 64 * nb, 64 * nb, nullptr, nullptr, scr, lane); continue; } r -= I_OUT;
        if (r < I_G) { const int kb = r / 88, nb = r % 88, n0 = 64 * nb; transpose_item(p->wgate, DFF, Wgu_t, DM, 64 * kb, n0, (n0 >> 7) * 256 + (n0 & 127), p->nffn, nullptr, scr, lane); continue; } r -= I_G;
        if (r < I_G) { const int kb = r / 88, nb = r % 88, n0 = 64 * nb; transpose_item(p->wup, DFF, Wgu_t, DM, 64 * kb, n0, (n0 >> 7) * 256 + 128 + (n0 & 127), p->nffn, nullptr, scr, lane); continue; } r -= I_G;
        if (r < I_D) { const int kb = r / 32, nb = r % 32; transpose_item(p->wdown, DM, Wd_t, DFF, 64 * kb, 64 * nb, 64 * nb, nullptr, nullptr, scr, lane); continue; } r -= I_D;
        { }
    }
    if (part & 2) for (int i = (blockIdx.x * NTHR + tid) * 4; i < 4 * 65536; i += G * NTHR * 4) { const f32x4 w4 = *(const f32x4*)(p->wpool + i); const f32x4 s4 = *(const f32x4*)(p->pscale + (i >> 16) * 256 + (i & 255));
        v2u o; o.x = pk2(w4[0] * s4[0], w4[1] * s4[1]); o.y = pk2(w4[2] * s4[2], w4[3] * s4[3]); *(v2u*)(Wp_t + i) = o; }
}

__device__ __forceinline__ float scan_add(float v, int) { return scan_add_dpp(v); }
__device__ __forceinline__ float scan_max(float v, int) { return scan_max_dpp(v); }
struct GateScan { float a, b, mt, g, m_new; };
__device__ __forceinline__ GateScan gate_scan(float gi, float gf, float bi, float bfv, bool valid, float m_c, int lane) {
    GateScan s;
    const float lf = valid ? logsigmoid(gf + bfv) : 0.f;
    s.b = scan_add(lf, lane);
    s.a = valid ? (gi + bi) - s.b : -INFINITY;
    const float cm = scan_max(s.a, lane);
    s.mt = s.b + fmaxf(m_c, cm);
    s.g = lane63(s.b);
    const float amax = lane63(cm);
    s.m_new = s.g + fmaxf(m_c, amax);
    return s;
}

typedef short s16x4 __attribute__((ext_vector_type(4)));
#define TR_READ(dst, addr, off) asm volatile("ds_read_b64_tr_b16 %0, %1 offset:%2" : "=&v"(dst) : "v"(addr), "i"(off) : "memory")
__device__ __forceinline__ bf16x8 cat8(s16x4 lo, s16x4 hi) { return __builtin_shufflevector(lo, hi, 0, 1, 2, 3, 4, 5, 6, 7); }

__device__ __forceinline__ void chain_unit(KP p, LAS unsigned char* lds, int tid, int lane, int wave, int bh, int sl) {
    const int b = bh >> 2, h = bh & 3;
    const bf16* P = (const bf16*)(p->ws + WS_P); const float* GATES = (const float*)(p->ws + WS_GATES);
    bf16* CT = (bf16*)(p->ws + WS_CT); float* NST = (float*)(p->ws + WS_NST); float* MST = (float*)(p->ws + WS_MST);
    constexpr int KSTR = 264, VSTR = 40, KBUF = 64 * KSTR * 2, VBUF = 64 * VSTR * 2;
    LAS unsigned char* Kb = lds;
    LAS unsigned char* Vb = lds + 2 * KBUF;
    LAS float* wtok = (LAS float*)(lds + 2 * KBUF + 2 * VBUF);
    LAS float* gL = wtok + 2112;
    LAS float* amL = gL + 40;
    LAS float* mch = amL + 40;
    LAS float* dec = mch + 40;
    const float bi = p->bi[h], bfv = p->bf[h];
    const int i16 = lane & 15, kq = lane >> 4;
    { float gi5[5], gf5[5];
#pragma unroll
      for (int k = 0; k < 5; ++k) { const int c = wave + 8 * k; const int L = c == 0 ? 16 : 64, t0 = c == 0 ? 0 : 16 + 64 * (c - 1); gi5[k] = 0.f; gf5[k] = 0.f;
          if (c < NCH && lane < L) { gi5[k] = GATES[(size_t)(b * TP + t0 + lane) * 8 + h]; gf5[k] = GATES[(size_t)(b * TP + t0 + lane) * 8 + 4 + h]; } }
#pragma unroll
      for (int k = 0; k < 5; ++k) { const int c = wave + 8 * k;
          if (c < NCH) { const int L = c == 0 ? 16 : 64, t0 = c == 0 ? 0 : 16 + 64 * (c - 1); const bool valid = lane < L;
              const float lf = valid ? logsigmoid(gf5[k] + bfv) : 0.f; const float bsum = scan_add(lf, lane); const float av = valid ? (gi5[k] + bi) - bsum : -INFINITY; const float cm = scan_max(av, lane);
              if (valid) wtok[t0 + lane] = av;
              if (lane == 63) { gL[c] = bsum; amL[c] = cm; } } } }
    LBAR();
    if (wave == 0) {
        const float gme = lane < NCH ? gL[lane] : 0.f, ame = lane < NCH ? amL[lane] : -INFINITY;
        float m = 0.f, m_at = 0.f, m_nx = 0.f;
#pragma unroll
        for (int c = 0; c < NCH; ++c) { const float g = __builtin_bit_cast(float, __builtin_amdgcn_readlane(__builtin_bit_cast(int, gme), c)), am = __builtin_bit_cast(float, __builtin_amdgcn_readlane(__builtin_bit_cast(int, ame), c));
            const float mn = g + fmaxf(m, am); if (lane == c) { m_at = m; m_nx = mn; } m = mn; }
        if (lane < NCH) { mch[lane] = m_at; dec[lane] = __expf(m_at + gme - m_nx); }
        if (lane == 0) mch[NCH] = m; }
    LBAR();
    for (int t = tid; t < TP; t += NTHR) { const int c = t < 16 ? 0 : 1 + ((t - 16) >> 6); wtok[t] = __expf(wtok[t] + gL[c] - mch[c + 1]) * 0.0625f; }
    if (sl == 0 && tid >= 1 && tid <= NCH) { if (tid < NCH) MST[bh * 34 + tid] = mch[tid]; else p->out[O_MP + bh] = mch[NCH]; }
    if (tid >= 2064 - 16 && tid < 2112) {}
    LBAR();
    float nval = 0.f;
    f32x4 acc[2][2];
#pragma unroll
    for (int a2 = 0; a2 < 2; ++a2)
#pragma unroll
        for (int c2 = 0; c2 < 2; ++c2) acc[a2][c2] = (f32x4){0.f, 0.f, 0.f, 0.f};
    v4u kA[4], kB[4]; v4u vA = (v4u){0u, 0u, 0u, 0u}, vB = vA;
#define CHAIN_ISSUE(cc, kreg, vreg) do { const int L_ = (cc) == 0 ? 16 : 64; const int r0_ = b * TP + ((cc) == 0 ? 0 : 16 + 64 * ((cc) - 1)); \
        _Pragma("unroll") for (int pp = 0; pp < 4; ++pp) { const int q_ = tid + 512 * pp, s_ = q_ >> 5, ch_ = q_ & 31; \
            kreg[pp] = s_ < L_ ? *(const v4u*)(P + (size_t)(r0_ + s_) * PW + 2048 + h * 256 + ch_ * 8) : (v4u){0u, 0u, 0u, 0u}; } \
        if (tid < 256) { const int s_ = tid >> 2, ch_ = tid & 3; vreg = s_ < L_ ? *(const v4u*)(P + (size_t)(r0_ + s_) * PW + 3072 + h * 256 + sl * 32 + ch_ * 8) : (v4u){0u, 0u, 0u, 0u}; } } while (0)
#define CHAIN_WRITE(cc, bufi, kreg, vreg) do { const int t0_ = (cc) == 0 ? 0 : 16 + 64 * ((cc) - 1); \
        _Pragma("unroll") for (int pp = 0; pp < 4; ++pp) { const int q_ = tid + 512 * pp, s_ = q_ >> 5, ch_ = q_ & 31; *(LAS v4u*)(Kb + (bufi) * KBUF + (s_ * KSTR + ch_ * 8) * 2) = kreg[pp]; } \
        if (tid < 256) { const int s_ = tid >> 2, ch_ = tid & 3; const float w_ = wtok[t0_ + s_]; v4u o_; \
            o_.x = pk2(bflo(vreg.x) * w_, bfhi(vreg.x) * w_); o_.y = pk2(bflo(vreg.y) * w_, bfhi(vreg.y) * w_); o_.z = pk2(bflo(vreg.z) * w_, bfhi(vreg.z) * w_); o_.w = pk2(bflo(vreg.w) * w_, bfhi(vreg.w) * w_); \
            *(LAS v4u*)(Vb + (bufi) * VBUF + (s_ * VSTR + ch_ * 8) * 2) = o_; } } while (0)
    CHAIN_ISSUE(0, kA, vA);
    CHAIN_WRITE(0, 0, kA, vA);
    CHAIN_ISSUE(1, kB, vB);
    CHAIN_ISSUE(2, kA, vA);
    LBAR();
    const int q4 = i16 >> 2, p4 = lane & 3;
    const unsigned aK0 = (unsigned)(size_t)Kb + (unsigned)(((8 * kq + q4) * KSTR + 32 * wave + 4 * p4) * 2);
    const unsigned aV0 = (unsigned)(size_t)Vb + (unsigned)(((8 * kq + q4) * VSTR + 4 * p4) * 2);
    const int ndk = tid & 31, nseg = tid >> 5;
#define CHAIN_STEP(c_, KR, VR) do { const int c = (c_); \
        const int buf = c & 1, t0 = c == 0 ? 0 : 16 + 64 * (c - 1); \
        const float decay = dec[c]; \
        const unsigned aK = aK0 + buf * KBUF, aV = aV0 + buf * VBUF; \
        s16x4 ra[2][2][2], rb[2][2][2]; \
        TR_READ(ra[0][0][0], aK, 0); TR_READ(ra[0][0][1], aK, 4 * KSTR * 2); TR_READ(ra[0][1][0], aK, 32); TR_READ(ra[0][1][1], aK, 4 * KSTR * 2 + 32); \
        TR_READ(rb[0][0][0], aV, 0); TR_READ(rb[0][0][1], aV, 4 * VSTR * 2); TR_READ(rb[0][1][0], aV, 32); TR_READ(rb[0][1][1], aV, 4 * VSTR * 2 + 32); \
        TR_READ(ra[1][0][0], aK, 32 * KSTR * 2); TR_READ(ra[1][0][1], aK, 36 * KSTR * 2); TR_READ(ra[1][1][0], aK, 32 * KSTR * 2 + 32); TR_READ(ra[1][1][1], aK, 36 * KSTR * 2 + 32); \
        TR_READ(rb[1][0][0], aV, 32 * VSTR * 2); TR_READ(rb[1][0][1], aV, 36 * VSTR * 2); TR_READ(rb[1][1][0], aV, 32 * VSTR * 2 + 32); TR_READ(rb[1][1][1], aV, 36 * VSTR * 2 + 32); \
        float ns = 0.f; \
        { const LAS unsigned short* kk = (const LAS unsigned short*)(Kb + buf * KBUF) + (4 * nseg) * KSTR + 32 * sl + ndk; \
_Pragma("unroll")           for (int e = 0; e < 4; ++e) ns += wtok[t0 + 4 * nseg + e] * bf2f(kk[e * KSTR]); } \
_Pragma("unroll")         for (int a2 = 0; a2 < 2; ++a2) \
_Pragma("unroll")             for (int c2 = 0; c2 < 2; ++c2) acc[a2][c2] = acc[a2][c2] * decay; \
        asm volatile("s_waitcnt lgkmcnt(0)" : "+v"(ra[0][0][0]), "+v"(ra[0][0][1]), "+v"(ra[0][1][0]), "+v"(ra[0][1][1]), "+v"(ra[1][0][0]), "+v"(ra[1][0][1]), "+v"(ra[1][1][0]), "+v"(ra[1][1][1]), \
                     "+v"(rb[0][0][0]), "+v"(rb[0][0][1]), "+v"(rb[0][1][0]), "+v"(rb[0][1][1]), "+v"(rb[1][0][0]), "+v"(rb[1][0][1]), "+v"(rb[1][1][0]), "+v"(rb[1][1][1]) :: "memory"); \
_Pragma("unroll")         for (int ks = 0; ks < 2; ++ks) \
_Pragma("unroll")             for (int mt = 0; mt < 2; ++mt) \
_Pragma("unroll")                 for (int nt = 0; nt < 2; ++nt) acc[mt][nt] = __builtin_amdgcn_mfma_f32_16x16x32_bf16(cat8(ra[ks][mt][0], ra[ks][mt][1]), cat8(rb[ks][nt][0], rb[ks][nt][1]), acc[mt][nt], 0, 0, 0); \
        nval = decay * nval + ns; \
        if (c + 1 < NCH) { CHAIN_WRITE(c + 1, buf ^ 1, KR, VR); if (c + 3 < NCH) CHAIN_ISSUE(c + 3, KR, VR); } \
        if (c + 1 < NCH) { \
            bf16* ct = CT + (size_t)(bh * NCH + c + 1) * 65536; \
_Pragma("unroll")             for (int mt = 0; mt < 2; ++mt) \
_Pragma("unroll")                 for (int nt = 0; nt < 2; ++nt) { const int dv = sl * 32 + 16 * nt + i16, dk = 32 * wave + 16 * mt + 4 * kq; const f32x4 v = acc[mt][nt]; \
                    v2u o; o.x = pk2(v[0], v[1]); o.y = pk2(v[2], v[3]); *(v2u*)(ct + (size_t)dv * 256 + dk) = o; } \
            NST[((size_t)(bh * 34 + c + 1) * 256 + 32 * sl + ndk) * 16 + nseg] = nval; \
        } \
        LBAR(); \
    } while (0)
    for (int cc = 0; cc + 1 < NCH; cc += 2) { CHAIN_STEP(cc, kB, vB); CHAIN_STEP(cc + 1, kA, vA); }
    CHAIN_STEP(NCH - 1, kB, vB);
#undef CHAIN_STEP
#undef CHAIN_ISSUE
#undef CHAIN_WRITE
    float* Cp = p->out + O_CP + (size_t)bh * 65536;
#pragma unroll
    for (int mt = 0; mt < 2; ++mt)
#pragma unroll
        for (int nt = 0; nt < 2; ++nt) { const int dv = sl * 32 + 16 * nt + i16, dk = 32 * wave + 16 * mt + 4 * kq;
#pragma unroll
            for (int j = 0; j < 4; ++j) Cp[(size_t)(dk + j) * 256 + dv] = acc[mt][nt][j]; }
    { LAS float* nf = (LAS float*)Kb; nf[ndk * 16 + nseg] = nval; LBAR();
      if (tid < 32) { float t = 0.f;
#pragma unroll
          for (int e = 0; e < 16; ++e) t += nf[tid * 16 + e];
          p->out[O_NP + (size_t)bh * 256 + 32 * sl + tid] = t; } }
    LBAR();
}

template <bool DO_H, bool DO_UPD>
__device__ __forceinline__ void sample_unit(KP p, LAS unsigned char* lds, int tid, int lane, int wave, int su) {
    const int sb = su >> 2, h = su & 3, row0 = RP + sb * 8;
    const bf16* P = (const bf16*)(p->ws + WS_P); const float* GATES = (const float*)(p->ws + WS_GATES); bf16* MIX = (bf16*)(p->ws + WS_MIX);
    LAS float* qT = (LAS float*)lds;
    LAS float* kT = (LAS float*)(lds + 8192);
    LAS float* kwT = (LAS float*)(lds + 16384);
    LAS float* vS = (LAS float*)(lds + 24576);
    LAS float* sc = (LAS float*)(lds + 32768);
    LAS float* red = (LAS float*)(lds + 36864);
    const float m0 = p->sm[su];
    const int s_ld = wave;
    const v2u q2 = *(const v2u*)(P + (size_t)(row0 + s_ld) * PW + 1024 + h * 256 + 4 * lane);
    const v2u k2 = *(const v2u*)(P + (size_t)(row0 + s_ld) * PW + 2048 + h * 256 + 4 * lane);
    const v2u v2 = *(const v2u*)(P + (size_t)(row0 + s_ld) * PW + 3072 + h * 256 + 4 * lane);
    v2u o2e = (v2u){0u, 0u}; f32x4 n4e = (f32x4){0.f, 0.f, 0.f, 0.f}, gne = n4e; float sne = 0.f;
    if constexpr (DO_H) { o2e = *(const v2u*)(P + (size_t)(row0 + s_ld) * PW + 4096 + h * 256 + 4 * lane); n4e = *(const f32x4*)(p->sn + (size_t)su * 256 + 4 * lane); gne = *(const f32x4*)(p->gnorm + h * 256 + 4 * lane); if (tid < 256) sne = p->sn[(size_t)su * 256 + tid]; }
    if (wave == 0) {
        float gi = 0.f, gf = 0.f; if (lane < 8) { gi = GATES[(size_t)(row0 + lane) * 8 + h]; gf = GATES[(size_t)(row0 + lane) * 8 + 4 + h]; }
        const GateScan gs = gate_scan(gi, gf, p->bi[h], p->bf[h], lane < 8, m0, lane);
        if (lane < 8) { sc[lane] = gs.a; sc[8 + lane] = gs.b - gs.mt; sc[16 + lane] = __expf(m0 + gs.b - gs.mt); sc[24 + lane] = __expf(-gs.mt); sc[32 + lane] = __expf(gs.a + gs.g - gs.m_new); }
        if (lane == 0) { sc[40] = __expf(m0 + gs.g - gs.m_new); sc[41] = gs.m_new; }
    }
    if constexpr (DO_H) {
      const float qv[4] = {bflo(q2.x), bfhi(q2.x), bflo(q2.y), bfhi(q2.y)}; const float kv[4] = {bflo(k2.x), bfhi(k2.x), bflo(k2.y), bfhi(k2.y)};
#pragma unroll
      for (int e = 0; e < 4; ++e) { const int dk = 4 * lane + e; qT[dk * 8 + s_ld] = qv[e]; }
      *(LAS f32x4*)(kT + s_ld * 256 + 4 * lane) = (f32x4){kv[0] * 0.0625f, kv[1] * 0.0625f, kv[2] * 0.0625f, kv[3] * 0.0625f};
      *(LAS f32x4*)(vS + s_ld * 256 + 4 * lane) = (f32x4){bflo(v2.x), bfhi(v2.x), bflo(v2.y), bfhi(v2.y)};
      LBAR();
    } else {
      LBAR();
      const float ws = sc[32 + s_ld]; const float kv[4] = {bflo(k2.x), bfhi(k2.x), bflo(k2.y), bfhi(k2.y)};
#pragma unroll
      for (int e = 0; e < 4; ++e) { const int dk = 4 * lane + e; kwT[dk * 8 + s_ld] = kv[e] * 0.0625f * ws; }
      *(LAS f32x4*)(vS + s_ld * 256 + 4 * lane) = (f32x4){bflo(v2.x), bfhi(v2.x), bflo(v2.y), bfhi(v2.y)};
      LBAR();
    }
    const float decay = sc[40];
    const int t = wave;
    float St[8]; float qn0 = 0.f;
#pragma unroll
    for (int s = 0; s < 8; ++s) St[s] = 0.f;
    if constexpr (DO_H) { float qd[4];
#pragma unroll
      for (int e = 0; e < 4; ++e) qd[e] = 0.f;
      qd[0] = bflo(q2.x); qd[1] = bfhi(q2.x); qd[2] = bflo(q2.y); qd[3] = bfhi(q2.y);
      const f32x4 n4 = n4e;
      qn0 = wave_sum((qd[0] * n4[0] + qd[1] * n4[1]) + (qd[2] * n4[2] + qd[3] * n4[3]));
      const float bm_t = sc[8 + t];
#pragma unroll
      for (int s = 0; s < 8; ++s) { float d = 0.f;
          { const f32x4 k4 = *(const LAS f32x4*)(kT + s * 256 + 4 * lane); d = (qd[0] * k4[0] + qd[1] * k4[1]) + (qd[2] * k4[2] + qd[3] * k4[3]); }
          d = wave_sum(d); St[s] = s <= t ? d * __expf(sc[s] + bm_t) : 0.f; } }
    { const int grp = wave, dv4 = 4 * lane;
      f32x4 vr[8], ac[8];
#pragma unroll
      for (int s = 0; s < 8; ++s) { vr[s] = *(const LAS f32x4*)(vS + s * 256 + dv4); ac[s] = (f32x4){0.f, 0.f, 0.f, 0.f}; }
      const float* C0 = p->sC + (size_t)su * 65536; float* C1 = p->out + O_CS + (size_t)su * 65536;
      f32x4 cb[2][8];
#pragma unroll
      for (int u = 0; u < 8; ++u) cb[0][u] = __builtin_nontemporal_load((const f32x4*)(C0 + (size_t)(grp + 8 * u) * 256 + dv4));
#pragma unroll
      for (int bt = 0; bt < 4; ++bt) { const int i0 = 8 * bt;
          if (bt < 3) {
#pragma unroll
              for (int u = 0; u < 8; ++u) cb[(bt + 1) & 1][u] = __builtin_nontemporal_load((const f32x4*)(C0 + (size_t)(grp + 8 * (i0 + 8 + u)) * 256 + dv4)); }
#pragma unroll
          for (int u = 0; u < 8; ++u) { const int dk = grp + 8 * (i0 + u); const f32x4 c4 = cb[bt & 1][u];
              const f32x4 qa = *(const LAS f32x4*)(qT + dk * 8), qb = *(const LAS f32x4*)(qT + dk * 8 + 4), ka = *(const LAS f32x4*)(kwT + dk * 8), kb = *(const LAS f32x4*)(kwT + dk * 8 + 4);
              if constexpr (DO_H) { ac[0] += qa[0] * c4; ac[1] += qa[1] * c4; ac[2] += qa[2] * c4; ac[3] += qa[3] * c4; ac[4] += qb[0] * c4; ac[5] += qb[1] * c4; ac[6] += qb[2] * c4; ac[7] += qb[3] * c4; }
              if constexpr (DO_UPD) { f32x4 cn = decay * c4; cn += ka[0] * vr[0]; cn += ka[1] * vr[1]; cn += ka[2] * vr[2]; cn += ka[3] * vr[3]; cn += kb[0] * vr[4]; cn += kb[1] * vr[5]; cn += kb[2] * vr[6]; cn += kb[3] * vr[7];
                  __builtin_nontemporal_store(cn, (f32x4*)(C1 + (size_t)dk * 256 + dv4)); } } }
      if constexpr (DO_H) {
#pragma unroll
          for (int s = 0; s < 8; ++s) *(LAS f32x4*)(red + (size_t)(grp * 8 + s) * 256 + dv4) = ac[s]; } }
    LBAR();
    if constexpr (DO_H) { const int dv4 = 4 * lane; f32x4 qc = (f32x4){0.f, 0.f, 0.f, 0.f};
#pragma unroll
      for (int g = 0; g < 8; ++g) qc += *(const LAS f32x4*)(red + (size_t)(g * 8 + t) * 256 + dv4);
      f32x4 sv = (f32x4){0.f, 0.f, 0.f, 0.f}; float ssum = 0.f;
#pragma unroll
      for (int s = 0; s < 8; ++s) { sv += St[s] * *(const LAS f32x4*)(vS + s * 256 + dv4); ssum += St[s]; }
      const float inter = sc[16 + t], em = sc[24 + t];
      const float qn = ssum + inter * qn0, den = fmaxf(fabsf(qn), em);
      const f32x4 hh = (sv + inter * qc) * __builtin_amdgcn_rcpf(den);
      const float ssq = wave_sum((hh[0] * hh[0] + hh[1] * hh[1]) + (hh[2] * hh[2] + hh[3] * hh[3]));
      const float rstd = 1.0f / sqrtf(ssq * (1.0f / 256.0f) + EPS);
      const v2u o2 = o2e; const f32x4 gn = gne;
      v2u y; y.x = pk2(hh[0] * rstd * gn[0] * sigmoidf(bflo(o2.x)), hh[1] * rstd * gn[1] * sigmoidf(bfhi(o2.x))); y.y = pk2(hh[2] * rstd * gn[2] * sigmoidf(bflo(o2.y)), hh[3] * rstd * gn[3] * sigmoidf(bfhi(o2.y)));
      *(v2u*)(MIX + (size_t)(row0 + t) * DM + 1024 + h * 256 + dv4) = y; }
    if constexpr (DO_H) {
    if (tid < 256) { float s = decay * sne;
#pragma unroll
        for (int e = 0; e < 8; ++e) s += kT[e * 256 + tid] * sc[32 + e];
        p->out[O_NS + (size_t)su * 256 + tid] = s; }
    if (tid == 0) p->out[O_MS + su] = sc[41]; }
    LBAR();
}

__device__ __forceinline__ void upd2_unit(KP p, LAS unsigned char* lds, int tid, int lane, int wave, int u) {
    const int sb = u >> 1, h0 = (u & 1) * 2, row0 = RP + sb * 8;
    const bf16* P = (const bf16*)(p->ws + WS_P); const float* GATES = (const float*)(p->ws + WS_GATES);
    LAS float* kwT = (LAS float*)lds;
    LAS float* vS = (LAS float*)(lds + 16384);
    LAS float* sc = (LAS float*)(lds + 32768);
    v2u k2[2], v2[2];
#pragma unroll
    for (int hh = 0; hh < 2; ++hh) { k2[hh] = *(const v2u*)(P + (size_t)(row0 + wave) * PW + 2048 + (h0 + hh) * 256 + 4 * lane); v2[hh] = *(const v2u*)(P + (size_t)(row0 + wave) * PW + 3072 + (h0 + hh) * 256 + 4 * lane); }
    if (wave < 2) { const int h = h0 + wave; const float m0 = p->sm[sb * 4 + h];
        float gi = 0.f, gf = 0.f; if (lane < 8) { gi = GATES[(size_t)(row0 + lane) * 8 + h]; gf = GATES[(size_t)(row0 + lane) * 8 + 4 + h]; }
        const GateScan gs = gate_scan(gi, gf, p->bi[h], p->bf[h], lane < 8, m0, lane);
        if (lane < 8) sc[wave * 64 + 32 + lane] = __expf(gs.a + gs.g - gs.m_new);
        if (lane == 0) sc[wave * 64 + 40] = __expf(m0 + gs.g - gs.m_new); }
    LBAR();
#pragma unroll
    for (int hh = 0; hh < 2; ++hh) { const float ws = sc[hh * 64 + 32 + wave] * 0.0625f; const float kv[4] = {bflo(k2[hh].x), bfhi(k2[hh].x), bflo(k2[hh].y), bfhi(k2[hh].y)};
#pragma unroll
        for (int e = 0; e < 4; ++e) kwT[hh * 2048 + (4 * lane + e) * 8 + wave] = kv[e] * ws;
        *(LAS f32x4*)(vS + hh * 2048 + wave * 256 + 4 * lane) = (f32x4){bflo(v2[hh].x), bfhi(v2[hh].x), bflo(v2[hh].y), bfhi(v2[hh].y)}; }
    LBAR();
    const int grp = wave, dv4 = 4 * lane;
#pragma unroll 1
    for (int hh = 0; hh < 2; ++hh) {
        const float decay = sc[hh * 64 + 40];
        f32x4 vr[8];
#pragma unroll
        for (int s = 0; s < 8; ++s) vr[s] = *(const LAS f32x4*)(vS + hh * 2048 + s * 256 + dv4);
        const float* C0 = p->sC + (size_t)(sb * 4 + h0 + hh) * 65536; float* C1 = p->out + O_CS + (size_t)(sb * 4 + h0 + hh) * 65536;
        const LAS float* kw = kwT + hh * 2048;
        f32x4 cb[2][8];
#pragma unroll
        for (int q = 0; q < 8; ++q) cb[0][q] = __builtin_nontemporal_load((const f32x4*)(C0 + (size_t)(grp + 8 * q) * 256 + dv4));
#pragma unroll
        for (int bt = 0; bt < 4; ++bt) { const int i0 = 8 * bt;
            if (bt < 3) {
#pragma unroll
                for (int q = 0; q < 8; ++q) cb[(bt + 1) & 1][q] = __builtin_nontemporal_load((const f32x4*)(C0 + (size_t)(grp + 8 * (i0 + 8 + q)) * 256 + dv4)); }
#pragma unroll
            for (int q = 0; q < 8; ++q) { const int dk = grp + 8 * (i0 + q); const f32x4 c4 = cb[bt & 1][q];
                const f32x4 ka = *(const LAS f32x4*)(kw + dk * 8), kb = *(const LAS f32x4*)(kw + dk * 8 + 4);
                f32x4 cn = decay * c4; cn += ka[0] * vr[0]; cn += ka[1] * vr[1]; cn += ka[2] * vr[2]; cn += ka[3] * vr[3]; cn += kb[0] * vr[4]; cn += kb[1] * vr[5]; cn += kb[2] * vr[6]; cn += kb[3] * vr[7];
                __builtin_nontemporal_store(cn, (f32x4*)(C1 + (size_t)dk * 256 + dv4)); } } }
    LBAR();
}

__device__ __forceinline__ void prompt_out_unit(KP p, LAS unsigned char* lds, int tid, int lane, int wave, int bh, int c) {
    const int b = bh >> 2, h = bh & 3, L = c == 0 ? 16 : 64, row0 = b * TP + (c == 0 ? 0 : 16 + 64 * (c - 1));
    const bf16* P = (const bf16*)(p->ws + WS_P); const float* GATES = (const float*)(p->ws + WS_GATES); bf16* MIX = (bf16*)(p->ws + WS_MIX);
    const bf16* CT = (const bf16*)(p->ws + WS_CT); const float* NST = (const float*)(p->ws + WS_NST); const float* MST = (const float*)(p->ws + WS_MST);
    constexpr int QSTR = 264;
    LAS unsigned short* Qs = (LAS unsigned short*)lds;
    LAS unsigned short* Ks = (LAS unsigned short*)(lds + 33792);
    LAS unsigned short* Vs = (LAS unsigned short*)(lds + 67584);
    LAS unsigned short* Ss = (LAS unsigned short*)(lds + 101376);
    LAS float* nL = (LAS float*)(lds + 110592);
    LAS float* aL = (LAS float*)(lds + 111616);
    LAS float* bmL = aL + 64;
    LAS float* interL = aL + 128;
    LAS float* emL = aL + 192;
    LAS float* rsum = (LAS float*)(lds + 112640);
    LAS float* qdn = (LAS float*)(lds + 113152);
    LAS float* hs = (LAS float*)(lds + 113408);
    LAS float* Hs = (LAS float*)lds;
    const int i16 = lane & 15, kq = lane >> 4;
    const float m_c = c ? MST[bh * 34 + c] : 0.f;
    const int dv0 = 32 * wave;
#pragma unroll 2
    for (int pp = 0; pp < 4; ++pp) { const int q = tid + 512 * pp, s = q >> 5, ch = q & 31; const bf16* src = P + (size_t)(row0 + s) * PW + h * 256 + ch * 8;
        v4u qv = (v4u){0u, 0u, 0u, 0u}, kv = qv, vv = qv;
        if (s < L) { qv = *(const v4u*)(src + 1024); kv = *(const v4u*)(src + 2048); vv = *(const v4u*)(src + 3072); }
        *(LAS v4u*)(Qs + s * QSTR + ch * 8) = qv; *(LAS v4u*)(Ks + s * QSTR + ch * 8) = kv; *(LAS v4u*)(Vs + s * QSTR + ch * 8) = vv; }
    asm volatile("" ::: "memory");
    bf16x8 bc[4][2];
    const bf16* ct = CT + ((size_t)(bh * NCH + c) * 256 + dv0) * 256;
    if (c > 0) {
#pragma unroll
        for (int ks = 0; ks < 4; ++ks)
#pragma unroll
            for (int nt = 0; nt < 2; ++nt) bc[ks][nt] = *(const bf16x8*)(ct + (size_t)(16 * nt + i16) * 256 + 32 * ks + 8 * kq); }
    if (tid < 256) { float nv = 0.f; if (c) { const f32x4* np4 = (const f32x4*)(NST + ((size_t)(bh * 34 + c) * 256 + tid) * 16); const f32x4 a0 = np4[0], a1 = np4[1], a2 = np4[2], a3 = np4[3];
            nv = (((a0[0] + a0[1]) + (a0[2] + a0[3])) + ((a1[0] + a1[1]) + (a1[2] + a1[3]))) + (((a2[0] + a2[1]) + (a2[2] + a2[3])) + ((a3[0] + a3[1]) + (a3[2] + a3[3]))); }
        nL[tid] = nv; }
    { float gi = 0.f, gf = 0.f; if (lane < L) { gi = GATES[(size_t)(row0 + lane) * 8 + h]; gf = GATES[(size_t)(row0 + lane) * 8 + 4 + h]; }
      const GateScan gs = gate_scan(gi, gf, p->bi[h], p->bf[h], lane < L, m_c, lane);
      if (wave == 0) { aL[lane] = gs.a; bmL[lane] = gs.b - gs.mt; interL[lane] = __expf(m_c + gs.b - gs.mt); emL[lane] = __expf(-gs.mt); } }
    LBAR();
    { const int mtw = wave >> 1, nh = wave & 1;
      f32x4 sa[2] = {(f32x4){0.f, 0.f, 0.f, 0.f}, (f32x4){0.f, 0.f, 0.f, 0.f}};
#pragma unroll
      for (int ks = 0; ks < 8; ++ks) { const bf16x8 A = *(const LAS bf16x8*)(Qs + (16 * mtw + i16) * QSTR + 32 * ks + 8 * kq);
#pragma unroll
          for (int nt = 0; nt < 2; ++nt) { const bf16x8 B = *(const LAS bf16x8*)(Ks + (32 * nh + 16 * nt + i16) * QSTR + 32 * ks + 8 * kq);
              sa[nt] = __builtin_amdgcn_mfma_f32_16x16x32_bf16(A, B, sa[nt], 0, 0, 0); } }
      float rs[4] = {0.f, 0.f, 0.f, 0.f};
#pragma unroll
      for (int nt = 0; nt < 2; ++nt) { const int s = 32 * nh + 16 * nt + i16; const float a_s = aL[s];
#pragma unroll
          for (int j = 0; j < 4; ++j) { const int t = 16 * mtw + 4 * kq + j; float v = 0.f;
              if (s <= t && t < L) v = sa[nt][j] * 0.0625f * __expf(a_s + bmL[t]);
              rs[j] += v; Ss[t * 72 + s] = (unsigned short)f2bf(v); } }
#pragma unroll
      for (int j = 0; j < 4; ++j) { const float v = row16_sum_dpp(rs[j]);
          if (i16 == 15) rsum[(16 * mtw + 4 * kq + j) * 2 + nh] = v; } }
    { const int t = tid >> 3, seg = tid & 7; float s = 0.f;
#pragma unroll
      for (int k8 = 0; k8 < 4; ++k8) { const v4u qw = *(const LAS v4u*)(Qs + t * QSTR + seg * 32 + 8 * k8);
          const f32x4 n0 = *(const LAS f32x4*)(nL + seg * 32 + 8 * k8), n1 = *(const LAS f32x4*)(nL + seg * 32 + 8 * k8 + 4);
          s += (bflo(qw.x) * n0[0] + bfhi(qw.x) * n0[1]) + (bflo(qw.y) * n0[2] + bfhi(qw.y) * n0[3]) + (bflo(qw.z) * n1[0] + bfhi(qw.z) * n1[1]) + (bflo(qw.w) * n1[2] + bfhi(qw.w) * n1[3]); }
      s = row8_sum_dpp(s);
      if (seg == 7) qdn[t] = s; }
    LBAR();
    f32x4 aV[4][2];
#pragma unroll
    for (int mt = 0; mt < 4; ++mt)
#pragma unroll
        for (int nt = 0; nt < 2; ++nt) aV[mt][nt] = (f32x4){0.f, 0.f, 0.f, 0.f};
    if (c > 0) {
#pragma unroll
        for (int ks = 0; ks < 4; ++ks) {
#pragma unroll
            for (int mt = 0; mt < 4; ++mt) { const bf16x8 A = *(const LAS bf16x8*)(Qs + (16 * mt + i16) * QSTR + 32 * ks + 8 * kq);
#pragma unroll
                for (int nt = 0; nt < 2; ++nt) aV[mt][nt] = __builtin_amdgcn_mfma_f32_16x16x32_bf16(A, bc[ks][nt], aV[mt][nt], 0, 0, 0); }
#pragma unroll
            for (int nt = 0; nt < 2; ++nt) bc[ks][nt] = *(const bf16x8*)(ct + (size_t)(16 * nt + i16) * 256 + 32 * (ks + 4) + 8 * kq);
            __builtin_amdgcn_sched_barrier(0); }
#pragma unroll
        for (int ks = 0; ks < 4; ++ks) {
#pragma unroll
            for (int mt = 0; mt < 4; ++mt) { const bf16x8 A = *(const LAS bf16x8*)(Qs + (16 * mt + i16) * QSTR + 32 * (ks + 4) + 8 * kq);
#pragma unroll
                for (int nt = 0; nt < 2; ++nt) aV[mt][nt] = __builtin_amdgcn_mfma_f32_16x16x32_bf16(A, bc[ks][nt], aV[mt][nt], 0, 0, 0); }
            __builtin_amdgcn_sched_barrier(0); }
#pragma unroll
        for (int mt = 0; mt < 4; ++mt) { const f32x4 i4 = *(const LAS f32x4*)(interL + 16 * mt + 4 * kq);
#pragma unroll
            for (int nt = 0; nt < 2; ++nt) aV[mt][nt] = aV[mt][nt] * i4; } }
    { const int q4 = i16 >> 2, p4 = lane & 3; const unsigned aVb = (unsigned)(size_t)Vs + (unsigned)(((8 * kq + q4) * QSTR + dv0 + 4 * p4) * 2);
      s16x4 rv[2][2][2];
      TR_READ(rv[0][0][0], aVb, 0); TR_READ(rv[0][0][1], aVb, 4 * QSTR * 2); TR_READ(rv[0][1][0], aVb, 32); TR_READ(rv[0][1][1], aVb, 4 * QSTR * 2 + 32);
      TR_READ(rv[1][0][0], aVb, 32 * QSTR * 2); TR_READ(rv[1][0][1], aVb, 36 * QSTR * 2); TR_READ(rv[1][1][0], aVb, 32 * QSTR * 2 + 32); TR_READ(rv[1][1][1], aVb, 36 * QSTR * 2 + 32);
      asm volatile("s_waitcnt lgkmcnt(0)" : "+v"(rv[0][0][0]), "+v"(rv[0][0][1]), "+v"(rv[0][1][0]), "+v"(rv[0][1][1]), "+v"(rv[1][0][0]), "+v"(rv[1][0][1]), "+v"(rv[1][1][0]), "+v"(rv[1][1][1]) :: "memory");
#pragma unroll
      for (int ks = 0; ks < 2; ++ks)
#pragma unroll
          for (int mt = 0; mt < 4; ++mt) { const bf16x8 A = *(const LAS bf16x8*)(Ss + (16 * mt + i16) * 72 + 32 * ks + 8 * kq);
#pragma unroll
              for (int nt = 0; nt < 2; ++nt) aV[mt][nt] = __builtin_amdgcn_mfma_f32_16x16x32_bf16(A, cat8(rv[ks][nt][0], rv[ks][nt][1]), aV[mt][nt], 0, 0, 0); } }
    v4u oreg[4];
#pragma unroll
    for (int pp = 0; pp < 4; ++pp) { const int q = tid + 512 * pp, t = q >> 5, ch = q & 31; oreg[pp] = t < L ? *(const v4u*)(P + (size_t)(row0 + t) * PW + 4096 + h * 256 + ch * 8) : (v4u){0u, 0u, 0u, 0u}; }
    LBAR();
#pragma unroll
    for (int mt = 0; mt < 4; ++mt)
#pragma unroll
        for (int j = 0; j < 4; ++j) { const int t = 16 * mt + 4 * kq + j; const float inter = interL[t]; const float qn = rsum[2 * t] + rsum[2 * t + 1] + inter * qdn[t];
            const float rden = 1.0f / fmaxf(fabsf(qn), emL[t]); float ssq = 0.f;
#pragma unroll
            for (int nt = 0; nt < 2; ++nt) { const float hv = aV[mt][nt][j] * rden; Hs[t * 260 + dv0 + 16 * nt + i16] = hv; ssq += hv * hv; }
            ssq = row16_sum_dpp(ssq);
            if (i16 == 15) hs[t * 8 + wave] = ssq; }
    LBAR();
#pragma unroll
    for (int pp = 0; pp < 4; ++pp) { const int q = tid + 512 * pp, t = q >> 5, ch = q & 31;
        if (t < L) { const f32x4 h0 = *(const LAS f32x4*)(hs + t * 8), h1 = *(const LAS f32x4*)(hs + t * 8 + 4);
            const float tot = ((h0[0] + h0[1]) + (h0[2] + h0[3])) + ((h1[0] + h1[1]) + (h1[2] + h1[3])); const float rstd = 1.0f / sqrtf(tot * (1.0f / 256.0f) + EPS);
            const f32x4 x0 = *(const LAS f32x4*)(Hs + t * 260 + 8 * ch), x1 = *(const LAS f32x4*)(Hs + t * 260 + 8 * ch + 4);
            const f32x4 g0 = *(const f32x4*)(p->gnorm + h * 256 + 8 * ch), g1 = *(const f32x4*)(p->gnorm + h * 256 + 8 * ch + 4);
            const v4u ov = oreg[pp]; v4u y;
            y.x = pk2(x0[0] * rstd * g0[0] * sigmoidf(bflo(ov.x)), x0[1] * rstd * g0[1] * sigmoidf(bfhi(ov.x))); y.y = pk2(x0[2] * rstd * g0[2] * sigmoidf(bflo(ov.y)), x0[3] * rstd * g0[3] * sigmoidf(bfhi(ov.y)));
            y.z = pk2(x1[0] * rstd * g1[0] * sigmoidf(bflo(ov.z)), x1[1] * rstd * g1[1] * sigmoidf(bfhi(ov.z))); y.w = pk2(x1[2] * rstd * g1[2] * sigmoidf(bflo(ov.w)), x1[3] * rstd * g1[3] * sigmoidf(bfhi(ov.w)));
            *(v4u*)(MIX + (size_t)(row0 + t) * DM + 1024 + h * 256 + 8 * ch) = y; }
        __builtin_amdgcn_sched_barrier(0); }
    LBAR();
}

__device__ __forceinline__ void unpack8(const v4u w, float (&f)[8]) { f[0] = bflo(w.x); f[1] = bfhi(w.x); f[2] = bflo(w.y); f[3] = bfhi(w.y); f[4] = bflo(w.z); f[5] = bfhi(w.z); f[6] = bflo(w.w); f[7] = bfhi(w.w); }
__device__ __forceinline__ void pool_rows(KP p, int lane, int gw, int NGW) {
    const bf16* P = (const bf16*)(p->ws + WS_P); bf16* D = (bf16*)(p->ws + WS_MIX);
    const int g = lane >> 4, w = 2 << g, ch0 = 16 * lane;
    for (int r = gw; r < R + 60 + 1920; r += NGW) {
        if (r < R) {
            int cnt, nloc, sb = 0, s = 0;
            if (r < RP) { const int t = r % TP; cnt = min(w, t + 1); nloc = cnt; }
            else { sb = (r - RP) >> 3; s = (r - RP) & 7; cnt = w; nloc = min(w, s + 1); }
#pragma unroll
            for (int half = 0; half < 2; ++half) { const int ch = ch0 + 8 * half; float sum[8], u0[8];
                v4u tb[16];
#pragma unroll
                for (int j = 0; j < 16; ++j) tb[j] = j < nloc ? *(const v4u*)(P + (size_t)(r - j) * PW + ch) : (v4u){0u, 0u, 0u, 0u};
                unpack8(tb[0], u0);
#pragma unroll
                for (int e = 0; e < 8; ++e) sum[e] = u0[e];
#pragma unroll
                for (int j = 1; j < 16; ++j) { float f[8]; unpack8(tb[j], f);
#pragma unroll
                    for (int e = 0; e < 8; ++e) sum[e] += f[e]; }
                for (int j = nloc; j < cnt; ++j) { const float* sp = p->spool + ((size_t)sb * 15 + (15 + s - j)) * 1024 + ch; const f32x4 a = *(const f32x4*)sp, bq = *(const f32x4*)(sp + 4);
                    sum[0] += a[0]; sum[1] += a[1]; sum[2] += a[2]; sum[3] += a[3]; sum[4] += bq[0]; sum[5] += bq[1]; sum[6] += bq[2]; sum[7] += bq[3]; }
                const float ic = 1.0f / (float)cnt; v4u o;
                o.x = pk2(sum[0] * ic - u0[0], sum[1] * ic - u0[1]); o.y = pk2(sum[2] * ic - u0[2], sum[3] * ic - u0[3]); o.z = pk2(sum[4] * ic - u0[4], sum[5] * ic - u0[5]); o.w = pk2(sum[6] * ic - u0[6], sum[7] * ic - u0[7]);
                *(v4u*)(D + (size_t)r * DM + ch) = o; }
        } else if (r < R + 60) {
            const int q = r - R, bb = q / 15, i = q % 15; const bf16* src = P + (size_t)(bb * TP + TP - 15 + i) * PW + ch0; float* dst = p->out + O_POOLP + (size_t)q * 1024 + ch0;
#pragma unroll
            for (int half = 0; half < 2; ++half) { float f[8]; unpack8(*(const v4u*)(src + 8 * half), f); *(f32x4*)(dst + 8 * half) = (f32x4){f[0], f[1], f[2], f[3]}; *(f32x4*)(dst + 8 * half + 4) = (f32x4){f[4], f[5], f[6], f[7]}; }
        } else {
            const int q = r - R - 60, sb = q / 15, i = q % 15; float* dst = p->out + O_POOLS + (size_t)q * 1024 + ch0;
            if (i < 7) { const float* src = p->spool + ((size_t)sb * 15 + 8 + i) * 1024 + ch0;
#pragma unroll
                for (int e = 0; e < 4; ++e) *(f32x4*)(dst + 4 * e) = *(const f32x4*)(src + 4 * e); }
            else { const bf16* src = P + (size_t)(RP + sb * 8 + i - 7) * PW + ch0;
#pragma unroll
                for (int half = 0; half < 2; ++half) { float f[8]; unpack8(*(const v4u*)(src + 8 * half), f); *(f32x4*)(dst + 8 * half) = (f32x4){f[0], f[1], f[2], f[3]}; *(f32x4*)(dst + 8 * half + 4) = (f32x4){f[4], f[5], f[6], f[7]}; } }
        }
    }
}

struct Args { Ptrs p; int ph_lo, ph_hi; };
#ifndef PG8_SP2
#define PG8_SP2 true
#endif
#ifndef PG8_ALIGN
#define PG8_ALIGN true
#endif
__global__ void __launch_bounds__(NTHR, 2) mk_fwd(Args args) {
    extern __shared__ __attribute__((aligned(16))) unsigned char lds_raw[];
    LAS unsigned char* lds = (LAS unsigned char*)lds_raw;
    const int tid = threadIdx.x, lane = tid & 63, wave = __builtin_amdgcn_readfirstlane(tid >> 6), G = gridDim.x;
    typedef const __attribute__((address_space(4))) Args* KA;
#define KARGS() ({ KA k_ = (KA)__builtin_amdgcn_kernarg_segment_ptr(); asm volatile("" : "+s"(k_)); k_; })
    const int lo = KARGS()->ph_lo, hi = KARGS()->ph_hi;
    cg::grid_group grid = cg::this_grid();
    volatile LAS unsigned* bst = (volatile LAS unsigned*)(lds + LDS_BYTES - 64);
    if (tid < 2) bst[tid] = 0u;
    __syncthreads();
    XcdBarrier xbar = xcd_barrier_post((unsigned*)(KARGS()->p.ws + WS_CTL), bst);
    if (hi == 0x7fff) grid.sync();
#ifndef PH_MASK
#define PH_MASK 0x1ff
#endif
#define IN(k) (((PH_MASK >> (k)) & 1) && lo <= (k) && (k) < hi)
#define SEAM(k) do { if (IN(k) && IN((k) + 1)) xcd_barrier(xbar); } while (0)
#define PHASE_PTRS() KP p = &KARGS()->p; unsigned char* ws = p->ws; (void)ws
    if (IN(0)) { PHASE_PTRS(); p0_prologue(p, lds, tid, lane, wave, G); }
#if defined(PROBE) && (PROBE == 1 || PROBE == 2)
    if (IN(0)) { xcd_barrier(xbar); PHASE_PTRS(); p0_prologue(p, lds, tid, lane, wave, G, PROBE); }
#elif defined(PROBE) && PROBE == 9
    if (IN(0)) { for (int q = 0; q < 10; ++q) xcd_barrier(xbar); }
#endif
    SEAM(0);
    if (IN(1)) { PHASE_PTRS(); pg8::Gemm g{(const bf16*)(ws + WS_XN), (const bf16*)(ws + WS_WIN), MP, PW, DM, DM, 0}; pg8::StaticOrder S; S.init(MP, PW, G, (int)blockIdx.x);
        pg8::EpiBf16 E{(bf16*)(ws + WS_P), PW}; pg8::gemm_phase<pg8::EpiBf16, pg8::StaticOrder, PG8_ALIGN, PG8_SP2>(lds, g, S, E);
        if (G == 256) { int k256 = 256; asm volatile("" : "+s"(k256));
            pg8::Gemm gf{(const bf16*)(ws + WS_WOUT), (const bf16*)(ws + WS_WP), DM, 1024, k256, DM, 512}; pg8::FoldOrder SF{(int)blockIdx.x - 228};
            pg8::EpiBf16 EF{(bf16*)(ws + WS_WOUT), DM}; pg8::gemm_phase<pg8::EpiBf16, pg8::FoldOrder, PG8_ALIGN, PG8_SP2>(lds, gf, SF, EF); } }
    SEAM(1);
    if (IN(2)) { PHASE_PTRS();
        const int bx = blockIdx.x;
        if (bx < 128) chain_unit(p, lds, tid, lane, wave, bx >> 3, bx & 7);
        if (G > 128) { if (bx >= 128) for (int su = bx - 128; su < 512; su += G - 128) sample_unit<true, false>(p, lds, tid, lane, wave, su); }
        else { for (int su = bx; su < 512; su += G) sample_unit<true, false>(p, lds, tid, lane, wave, su); }
        if (G < 128) for (int cu = bx + G; cu < 128; cu += G) chain_unit(p, lds, tid, lane, wave, cu >> 3, cu & 7);
    }
#if defined(PROBE) && PROBE == 21
    if (IN(2)) { xcd_barrier(xbar); PHASE_PTRS(); const int bx = blockIdx.x; if (bx < 128) chain_unit(p, lds, tid, lane, wave, bx >> 3, bx & 7); }
#elif defined(PROBE) && PROBE == 22
    if (IN(2)) { xcd_barrier(xbar); PHASE_PTRS(); const int bx = blockIdx.x; if (bx >= 128) for (int su = bx - 128; su < 512; su += G - 128) sample_unit<true, false>(p, lds, tid, lane, wave, su); }
#endif
    SEAM(2);
    if (IN(3)) { PHASE_PTRS();
        for (int u = blockIdx.x; u < 16 * NCH; u += G) prompt_out_unit(p, lds, tid, lane, wave, u / NCH, u % NCH);
        if (G > 32) { if (blockIdx.x >= 16) pool_rows(p, lane, (blockIdx.x - 16) * NWAVES + wave, (G - 16) * NWAVES); }
        else pool_rows(p, lane, blockIdx.x * NWAVES + wave, G * NWAVES);
    }
#if defined(PROBE) && PROBE == 31
    if (IN(3)) { xcd_barrier(xbar); PHASE_PTRS(); for (int u = blockIdx.x; u < 16 * NCH; u += G) prompt_out_unit(p, lds, tid, lane, wave, u / NCH, u % NCH); }
#elif defined(PROBE) && PROBE == 32
    if (IN(3)) { xcd_barrier(xbar); PHASE_PTRS(); pool_rows(p, lane, blockIdx.x * NWAVES + wave, G * NWAVES); }
#endif
    SEAM(3);

    if (IN(5)) { PHASE_PTRS(); pg8::Gemm g{(const bf16*)(ws + WS_MIX), (const bf16*)(ws + WS_WOUT), MP, DM, DM, DM, 0};
        pg8::EpiOut E{(float*)(ws + WS_X1), (bf16*)(ws + WS_XN), (float*)(ws + WS_SS1), pg8::RowMap{p->xp, p->xs, p->meta, nullptr, nullptr}};
#pragma unroll 1
        for (int st = 0; st < 2; ++st) { pg8::OutOrder S{(int)blockIdx.x, st}; pg8::gemm_phase<pg8::EpiOut, pg8::OutOrder, PG8_ALIGN, PG8_SP2>(lds, g, S, E); if (st == 0) xcd_barrier(xbar); }
    }
    if (IN(6)) { PHASE_PTRS(); pg8::Gemm g{(const bf16*)(ws + WS_XN), (const bf16*)(ws + WS_WGU), MP, 2 * DFF, DM, DM, 0};
        pg8::EpiGU E{(bf16*)(ws + WS_H), DFF, (const float*)(ws + WS_SS1), EPS};
#pragma unroll 1
        for (int st = 0; st < 2; ++st) { pg8::GuOrder S{(int)blockIdx.x, st}; pg8::gemm_phase<pg8::EpiGU, pg8::GuOrder, PG8_ALIGN, PG8_SP2>(lds, g, S, E);
            if (st == 0) { if (blockIdx.x >= 132) for (int uu = blockIdx.x - 132; uu < 248; uu += 124) upd2_unit(p, lds, tid, lane, wave, uu); xcd_barrier(xbar); } }
    }
    SEAM(6);
    if (IN(7)) { PHASE_PTRS(); pg8::Gemm g{(const bf16*)(ws + WS_H), (const bf16*)(ws + WS_WD), MP, DM, DFF, DFF, 0}; pg8::DownOrder S{(int)blockIdx.x};
        pg8::EpiDown E{(const float*)(ws + WS_X1), (float*)(ws + WS_SLAB), pg8::RowMap{nullptr, nullptr, nullptr, p->out + O_YP, p->out + O_YS}};
        pg8::gemm_phase<pg8::EpiDown, pg8::DownOrder, PG8_ALIGN, PG8_SP2>(lds, g, S, E);
        if (blockIdx.x >= 160 && blockIdx.x < 168) upd2_unit(p, lds, tid, lane, wave, 248 + (int)blockIdx.x - 160); }
    SEAM(7);
    if (IN(8)) { PHASE_PTRS();
        const float* X1 = (const float*)(ws + WS_X1); const float* slab = (const float*)(ws + WS_SLAB); const float* nfin = p->nfinal; float* yb = p->out + O_YP;
        const int gw = blockIdx.x * NWAVES + wave, NGW = G * NWAVES;
#define P8_ROW(o_) ((o_) < 8192 ? ((o_) >> 11) * TP + 16 + ((o_) & 2047) : RP + ((o_) - 8192))
        f32x4 vn[8];
        if (gw < 9216 && P8_ROW(gw) < 8192) { const f32x4* y4 = (const f32x4*)(yb + (size_t)gw * DM) + lane;
#pragma unroll
            for (int j = 0; j < 8; ++j) vn[j] = y4[64 * j]; }
        for (int o = gw; o < 9216; o += NGW) { const int r = P8_ROW(o);
            f32x4* y4 = (f32x4*)(yb + (size_t)o * DM) + lane; f32x4 v[8]; float s = 0.f;
            if (r < 8192) {
#pragma unroll
                for (int j = 0; j < 8; ++j) v[j] = vn[j];
            } else { const f32x4* x4 = (const f32x4*)(X1 + (size_t)r * DM) + lane; const f32x4* s4 = (const f32x4*)(slab + (size_t)(r - 8192) * DM) + lane;
#pragma unroll
                for (int j = 0; j < 8; ++j) v[j] = x4[64 * j] + ((s4[64 * j] + s4[64 * j + 1280 * DM / 4]) + (s4[64 * j + 2 * (1280 * DM / 4)] + s4[64 * j + 3 * (1280 * DM / 4)])); }
            const int on = o + NGW;
            if (on < 9216 && P8_ROW(on) < 8192) { const f32x4* yn = (const f32x4*)(yb + (size_t)on * DM) + lane;
#pragma unroll
                for (int j = 0; j < 8; ++j) vn[j] = yn[64 * j]; }
#pragma unroll
            for (int j = 0; j < 8; ++j) s += (v[j][0] * v[j][0] + v[j][1] * v[j][1]) + (v[j][2] * v[j][2] + v[j][3] * v[j][3]);
            const float rstd = 1.0f / sqrtf(wave_sum(s) * (1.0f / DM) + EPS);
#pragma unroll
            for (int j = 0; j < 8; ++j) { const f32x4 w4 = ((const f32x4*)nfin)[64 * j + lane]; y4[64 * j] = v[j] * rstd * w4; } }
#undef P8_ROW
    }
#undef IN
#undef SEAM
}

extern "C" void kernel_launch(void* const* d_in, const int* in_sizes, int n_in, void* d_out, int out_size, void* d_ws, size_t ws_size, hipStream_t stream) {
    static int grid = 0;
    if (grid == 0) {
        if (n_in != 20 || (size_t)out_size != O_END || ws_size < WS_END) { fprintf(stderr, "kernel_launch: unexpected shapes: n_in %d out %d ws %zu\n", n_in, out_size, ws_size); grid = -1; return; }
        int dev = 0, cus = 0, per_cu = 0;
        (void)hipGetDevice(&dev); (void)hipDeviceGetAttribute(&cus, hipDeviceAttributeMultiprocessorCount, dev);
        if (hipFuncSetAttribute((const void*)mk_fwd, hipFuncAttributeMaxDynamicSharedMemorySize, LDS_BYTES) != hipSuccess) { fprintf(stderr, "kernel_launch: hipFuncSetAttribute failed\n"); grid = -1; return; }
        if (hipOccupancyMaxActiveBlocksPerMultiprocessor(&per_cu, (const void*)mk_fwd, NTHR, LDS_BYTES) != hipSuccess || per_cu < 1) { fprintf(stderr, "kernel_launch: occupancy query gave %d\n", per_cu); (void)hipGetLastError(); per_cu = 1; }
        if (cus < 256) { fprintf(stderr, "kernel_launch: needs 256 CUs, found %d\n", cus); grid = -1; return; }
        grid = 256;
    }
    if (grid < 0) return;
    Args a{};
    const float** pp = (const float**)&a.p;
    for (int i = 0; i < 20; ++i) pp[i] = (const float*)d_in[i];
    a.p.out = (float*)d_out; a.p.ws = (unsigned char*)d_ws;
#if ONE_LAUNCH
    if (hipMemsetAsync((char*)d_ws + WS_CTL, 0, CTL_BYTES, stream) != hipSuccess) { fprintf(stderr, "kernel_launch: memset failed\n"); return; }
    a.ph_lo = 0; a.ph_hi = 9;
    void* kargs[] = {&a};
    hipError_t e = hipLaunchCooperativeKernel((const void*)mk_fwd, dim3(grid), dim3(NTHR), kargs, LDS_BYTES, stream);
    if (e != hipSuccess) fprintf(stderr, "cooperative launch failed: %s (grid %d)\n", hipGetErrorString(e), grid);
#else
    for (int ph = 0; ph < 9; ++ph) { a.ph_lo = ph; a.ph_hi = ph + 1; hipLaunchKernelGGL(mk_fwd, dim3(grid), dim3(NTHR), LDS_BYTES, stream, a); }
#endif
}
```

```cpp
#include <hip/hip_runtime.h>
#include <hip/hip_cooperative_groups.h>
#include <cstdio>
#include <cstdint>
namespace cg = cooperative_groups;
#ifndef ONE_LAUNCH
#define ONE_LAUNCH 1
#endif
namespace pg8 {
#define PG8_LAS __attribute__((address_space(3)))
typedef unsigned short bf16_t;
typedef short bf16x8 __attribute__((ext_vector_type(8)));
typedef float f32x4 __attribute__((ext_vector_type(4)));
typedef unsigned u32x4 __attribute__((ext_vector_type(4)));
constexpr int BM = 256, BK = 64, HALF = 128, HTB = HALF * BK * 2  , STAGE_BYTES = 8 * HTB, NXCD = 8, WGM = 8;

__host__ __device__ __forceinline__ int lds_byte(int r, int c) { const int st = (r >> 4) * 2 + (c >> 5), rr = r & 15, cc = c & 31, ob = rr * 64 + cc * 2; return st * 1024 + (ob ^ (((ob >> 9) & 1) << 5)); }
__host__ __device__ __forceinline__ void stage_rc(int b, int& R, int& C) { const int st = b / 1024, sb = b % 1024, swz = sb ^ (((sb >> 9) & 1) << 5); R = (st >> 1) * 16 + swz / 64; C = (st & 1) * 32 + (swz % 64) / 2; }
__host__ __device__ __forceinline__ int perm32(int rho) { const int n = rho >> 4, i = rho & 15; return 8 * (i >> 2) + 4 * n + (i & 3); }

struct Unit { int pm, pn, kt0, nt; };
struct Gemm { const bf16_t* A; const bf16_t* Bt; int M, N, K, lda, a_pn_bytes; };

struct StaticOrder {
    int nM, nN, nwg, G, c;
    __host__ __device__ void init(int M, int N, int G_, int c_) { nM = M / BM; nN = N / BM; nwg = nM * nN; G = G_; c = c_; }
    __host__ __device__ bool next(int i, Unit& u) const {
        const long L = (long)i * G + c; if (L >= nwg) return false;
        int wgid = (int)L; { const int q = nwg / NXCD, r = nwg % NXCD, xcd = wgid % NXCD, off = wgid / NXCD; wgid = (xcd < r ? xcd * (q + 1) : r * (q + 1) + (xcd - r) * q) + off; }
        const int nig = WGM * nN, gid = wgid / nig, fm = gid * WGM, gsz = (nM - fm) < WGM ? (nM - fm) : WGM;
        u.pm = fm + ((wgid % nig) % gsz); u.pn = (wgid % nig) / gsz; u.kt0 = 0; u.nt = 0; return true;
    }
    __device__ __forceinline__ void a_ready(const Unit&) const {}
    __device__ __forceinline__ void done(const Unit&) const {}
};

__device__ __forceinline__ unsigned cvt_pk_bf16(float lo, float hi) { unsigned r; asm volatile("v_cvt_pk_bf16_f32 %0, %1, %2" : "=v"(r) : "v"(lo), "v"(hi)); return r; }
typedef float f32x2 __attribute__((ext_vector_type(2)));
constexpr int kDM = 2048, kTP = 2064, kRP = 4 * 2064, kR = 9280, kMP = 9472;
struct RowMap { const float* xp; const float* xs; const float* meta; float* yp; float* ys; };
__device__ __forceinline__ const float* xrow_ptr(const RowMap& rm, int row) {
    if (row < kRP) { const int b = row / kTP, t = row - b * kTP; return t < 16 ? rm.meta + (size_t)t * kDM : rm.xp + ((size_t)b * 2048 + (t - 16)) * kDM; }
    return rm.xs + (size_t)(row - kRP) * kDM;
}
__device__ __forceinline__ float* yrow_ptr(const RowMap& rm, int row) {
    if (row < kRP) { const int b = row / kTP, t = row - b * kTP; return t < 16 ? nullptr : rm.yp + ((size_t)b * 2048 + (t - 16)) * kDM; }
    return rm.ys + (size_t)(row - kRP) * kDM;
}
typedef unsigned u32x2 __attribute__((ext_vector_type(2)));
struct EpiBf16 {
    static constexpr bool PERM = true, AFTER_DRAIN = false;
    __device__ __forceinline__ void prefetch_lds(const Unit&, PG8_LAS unsigned char*, int, int) const {}
    bf16_t* O; int ldc;
    __device__ __forceinline__ void operator()(const f32x4 (&acc)[2][2][4][2], const Unit& u, int wr, int wc, int fr, int fq, const PG8_LAS unsigned char* xl) const {
        const int row0 = u.pm * BM + wr * 64 + fr, col0 = u.pn * BM + wc * 32 + 8 * fq;
#pragma unroll
        for (int ai = 0; ai < 2; ++ai)
#pragma unroll
            for (int m = 0; m < 4; ++m) { bf16_t* rowp = O + (size_t)(row0 + ai * HALF + m * 16) * ldc + col0;
#pragma unroll
                for (int bj = 0; bj < 2; ++bj) { const f32x4 v0 = acc[ai][bj][m][0], v1 = acc[ai][bj][m][1];
                    u32x4 w; w.x = cvt_pk_bf16(v0[0], v0[1]); w.y = cvt_pk_bf16(v0[2], v0[3]); w.z = cvt_pk_bf16(v1[0], v1[1]); w.w = cvt_pk_bf16(v1[2], v1[3]);
                    *(u32x4*)(rowp + bj * HALF) = w; } }
    }
};
__device__ __forceinline__ float silu_mul(float g, float u) { return g * __builtin_amdgcn_rcpf(1.f + __expf(-g)) * u; }
struct EpiGU {
    static constexpr bool PERM = true, AFTER_DRAIN = false;
    __device__ __forceinline__ void prefetch_lds(const Unit& u, PG8_LAS unsigned char* xl, int wid, int lane) const {
        if (wid == 0) __builtin_amdgcn_global_load_lds((const unsigned*)(ss + u.pm * BM + 4 * lane), (PG8_LAS unsigned*)xl, 16, 0, 0); }
    bf16_t* H; int ldh; const float* ss; float eps;
    __device__ __forceinline__ void operator()(const f32x4 (&acc)[2][2][4][2], const Unit& u, int wr, int wc, int fr, int fq, const PG8_LAS unsigned char* xl) const {
        const int row0 = u.pm * BM + wr * 64 + fr, col0 = u.pn * HALF + wc * 32 + 8 * fq;
#pragma unroll
        for (int ai = 0; ai < 2; ++ai)
#pragma unroll
            for (int m = 0; m < 4; ++m) { const int row = row0 + ai * HALF + m * 16; const float rs = 1.0f / sqrtf(*(const PG8_LAS float*)(xl + 4 * (row - u.pm * BM)) * (1.0f / 2048.0f) + eps);
                const f32x4 g0 = acc[ai][0][m][0] * rs, g1 = acc[ai][0][m][1] * rs, u0 = acc[ai][1][m][0] * rs, u1 = acc[ai][1][m][1] * rs;
                u32x4 w; w.x = cvt_pk_bf16(silu_mul(g0[0], u0[0]), silu_mul(g0[1], u0[1])); w.y = cvt_pk_bf16(silu_mul(g0[2], u0[2]), silu_mul(g0[3], u0[3]));
                w.z = cvt_pk_bf16(silu_mul(g1[0], u1[0]), silu_mul(g1[1], u1[1])); w.w = cvt_pk_bf16(silu_mul(g1[2], u1[2]), silu_mul(g1[3], u1[3]));
                *(u32x4*)(H + (size_t)row * ldh + col0) = w; }
    }
};
struct EpiOut {
    static constexpr bool PERM = false, AFTER_DRAIN = false;
    __device__ __forceinline__ void prefetch_lds(const Unit&, PG8_LAS unsigned char*, int, int) const {}
    float* X1; bf16_t* X1B; float* ss; RowMap rm;
    __device__ __forceinline__ void operator()(const f32x4 (&acc)[2][2][4][2], const Unit& u, int wr, int wc, int fr, int fq, const PG8_LAS unsigned char* xl) const {
        const int col0 = u.pn * BM + wc * 32 + 4 * fq;
#pragma unroll
        for (int ai = 0; ai < 2; ++ai)
#pragma unroll
            for (int m = 0; m < 4; ++m) { const int row = u.pm * BM + ai * HALF + wr * 64 + m * 16 + fr;
                if (row < kR) { const float* xr = xrow_ptr(rm, row); float s = 0.f;
#pragma unroll
                    for (int bj = 0; bj < 2; ++bj)
#pragma unroll
                        for (int n = 0; n < 2; ++n) { const int c = col0 + bj * HALF + n * 16; const f32x4 v = *(const f32x4*)(xr + c) + acc[ai][bj][m][n];
                            *(f32x4*)(X1 + (size_t)row * kDM + c) = v; u32x2 w; w.x = cvt_pk_bf16(v[0], v[1]); w.y = cvt_pk_bf16(v[2], v[3]);
                            *(u32x2*)(X1B + (size_t)row * kDM + c) = w; s += (v[0] * v[0] + v[1] * v[1]) + (v[2] * v[2] + v[3] * v[3]); }
                    s += __shfl_xor(s, 16); s += __shfl_xor(s, 32);
                    if (fq == 0) atomicAdd(ss + row, s); } }
    }
};
struct EpiDown {
    static constexpr bool PERM = false, AFTER_DRAIN = false;
    __device__ __forceinline__ void prefetch_lds(const Unit&, PG8_LAS unsigned char*, int, int) const {}
    const float* X1; float* slab; RowMap rm;
    __device__ __forceinline__ void operator()(const f32x4 (&acc)[2][2][4][2], const Unit& u, int wr, int wc, int fr, int fq, const PG8_LAS unsigned char* xl) const {
        const int col0 = u.pn * BM + wc * 32 + 4 * fq;
        if (u.nt == 22) { float* sl = slab + (size_t)(u.kt0 / 22) * (1280 * kDM);
#pragma unroll
            for (int ai = 0; ai < 2; ++ai)
#pragma unroll
                for (int m = 0; m < 4; ++m) { const int row = u.pm * BM + ai * HALF + wr * 64 + m * 16 + fr;
                    if (row < kR) {
#pragma unroll
                        for (int bj = 0; bj < 2; ++bj)
#pragma unroll
                            for (int n = 0; n < 2; ++n) *(f32x4*)(sl + (size_t)(row - 8192) * kDM + col0 + bj * HALF + n * 16) = acc[ai][bj][m][n]; } }
            return; }
#pragma unroll
        for (int ai = 0; ai < 2; ++ai)
#pragma unroll
            for (int m = 0; m < 4; ++m) { const int row = u.pm * BM + ai * HALF + wr * 64 + m * 16 + fr;
                if (row < kR) { float* yr = yrow_ptr(rm, row);
                    if (yr) {
#pragma unroll
                    for (int bj = 0; bj < 2; ++bj)
#pragma unroll
                        for (int n = 0; n < 2; ++n) { const int c = col0 + bj * HALF + n * 16; *(f32x4*)(yr + c) = *(const f32x4*)(X1 + (size_t)row * kDM + c) + acc[ai][bj][m][n]; } } } }
    }
};
struct OutOrder {
    int c, mode;
    __device__ __forceinline__ bool next(int i, Unit& u) const {
        if (i != 0) return false;
        u.kt0 = 0; u.nt = 0;
        if (mode == 0) { const int xcd = c & 7, slot = c >> 3, L = xcd * 32 + slot; u.pm = (L >> 6) * 8 + (L & 7); u.pn = (L >> 3) & 7; return true; }
        if (c < 40) { u.pm = 32 + (c >> 3); u.pn = c & 7; return true; }
        return false;
    }
    __device__ __forceinline__ void a_ready(const Unit&) const {}
    __device__ __forceinline__ void done(const Unit&) const {}
};
struct GuOrder {
    int c, mode;
    static __device__ __forceinline__ void decode(int N, Unit& u) { u.kt0 = 0; u.nt = 0; if (N < 1408) { const int g = N / 352, r = N - g * 352; u.pn = r >> 3; u.pm = 8 * g + (r & 7); } else { const int r = N - 1408; u.pn = r / 5; u.pm = 32 + (r - 5 * u.pn); } }
    __device__ __forceinline__ bool next(int i, Unit& u) const {
        if (mode == 0) { if (i == 0 && c >= 40 && c < 132) { decode(c - 40, u); return true; } return false; }
        if (i < 6) { const int xcd = c & 7, slot = c >> 3; decode(92 + i * 256 + xcd * 32 + slot, u); return true; }
        return false;
    }
    __device__ __forceinline__ void a_ready(const Unit&) const {}
    __device__ __forceinline__ void done(const Unit&) const {}
};
struct FoldOrder {
    int c;
    __device__ __forceinline__ bool next(int i, Unit& u) const { const int j = c + 28 * i; if (c < 0 || i > 1 || j >= 32) return false; u.pm = j >> 2; u.pn = j & 3; u.kt0 = 0; u.nt = 0; return true; }
    __device__ __forceinline__ void a_ready(const Unit&) const {}
    __device__ __forceinline__ void done(const Unit&) const {}
};
struct DownOrder {
    int c;
    __device__ __forceinline__ bool next(int i, Unit& u) const {
        if (i == 0) { const int xcd = c & 7, slot = c >> 3; const int L = xcd * 32 + slot; u.pm = (L >> 6) * 8 + (L & 7); u.pn = (L >> 3) & 7; u.kt0 = 0; u.nt = 0; return true; }
        if (i == 1 && c < 160) { const int q = c >> 2; u.pm = 32 + (q >> 3); u.pn = q & 7; u.kt0 = 22 * (c & 3); u.nt = 22; return true; }
        return false;
    }
    __device__ __forceinline__ void a_ready(const Unit&) const {}
    __device__ __forceinline__ void done(const Unit&) const {}
};
template <class Epi, class Sched, bool ALIGN_EPI = false, bool SP2 = false>
__device__ __forceinline__ void gemm_phase(PG8_LAS unsigned char* lds, const Gemm g, const Sched& S, const Epi& E) {
    const int tid = threadIdx.x, wid = __builtin_amdgcn_readfirstlane(tid >> 6), lane = tid & 63, wr = wid >> 2, wc = wid & 3, fr = lane & 15, fq = lane >> 4;
    const int K = g.K, nt = K / BK;
    unsigned voffA[2], voffB[2];
#pragma unroll
    for (int i = 0; i < 2; ++i) { int R, C; stage_rc(tid * 16 + i * 8192, R, C); const int Rb = Epi::PERM ? ((R & ~31) + perm32(R & 31)) : R;
        voffA[i] = (unsigned)(R * g.lda + C) * 2u; voffB[i] = (unsigned)(Rb * K + C) * 2u; }
    const size_t kstep = (size_t)(BK * 2);
    const size_t hstepA = (size_t)HALF * g.lda * 2, hstepB = (size_t)HALF * K * 2;
    const size_t tstepA = 2 * hstepA, tstepB = 2 * hstepB;
    const unsigned ldsw = (unsigned)wid * 1024u;
    const int aoff = lds_byte(wr * 64 + fr, fq * 8), boff = lds_byte(wc * 32 + fr, fq * 8);
#define PG8_SA(b, h) (((b) * 2 + (h)) * HTB)
#define PG8_SB(b, h) ((4 + (b) * 2 + (h)) * HTB)
#define PG8_STAGE(bufoff, gbase, voff) do { _Pragma("unroll") for (int _i = 0; _i < 2; ++_i) \
        __builtin_amdgcn_global_load_lds((const unsigned*)((const char*)(gbase) + (voff)[_i]), (PG8_LAS unsigned*)(lds + (bufoff) + ldsw + _i * 8192), 16, 0, 0); } while (0)
#define PG8_LDA(dst, b, h) do { _Pragma("unroll") for (int m = 0; m < 4; ++m) _Pragma("unroll") for (int k = 0; k < 2; ++k) dst[m][k] = *(const PG8_LAS bf16x8*)(lds + PG8_SA(b, h) + aoff + m * 2048 + k * 1024); } while (0)
#define PG8_LDB(dst, b, h) do { _Pragma("unroll") for (int n = 0; n < 2; ++n) _Pragma("unroll") for (int k = 0; k < 2; ++k) dst[n][k] = *(const PG8_LAS bf16x8*)(lds + PG8_SB(b, h) + boff + n * 2048 + k * 1024); } while (0)
#define PG8_MMA(ai, bj, At, Bt) do { __builtin_amdgcn_s_setprio(1); _Pragma("unroll") for (int m = 0; m < 4; ++m) _Pragma("unroll") for (int n = 0; n < 2; ++n) _Pragma("unroll") for (int k = 0; k < 2; ++k) \
        acc[ai][bj][m][n] = __builtin_amdgcn_mfma_f32_16x16x32_bf16(Bt[n][k], At[m][k], acc[ai][bj][m][n], 0, 0, 0); __builtin_amdgcn_s_setprio(0); } while (0)
#define PG8_WAIT_V(n) asm volatile("s_waitcnt vmcnt(" #n ")" ::: "memory")
#define PG8_WAIT_L(n) asm volatile("s_waitcnt lgkmcnt(" #n ")" ::: "memory")
#define PG8_BAR __builtin_amdgcn_s_barrier()
#define PG8_SCHED __builtin_amdgcn_sched_barrier(0)
    Unit cur, nxt; int ui = 0;
    if (!S.next(0, cur)) return;
    f32x4 acc[2][2][4][2];
#pragma unroll
    for (int a = 0; a < 2; ++a)
#pragma unroll
        for (int b = 0; b < 2; ++b)
#pragma unroll
            for (int m = 0; m < 4; ++m)
#pragma unroll
                for (int n = 0; n < 2; ++n) acc[a][b][m][n] = (f32x4){0.f, 0.f, 0.f, 0.f};
    bf16x8 At[4][2], B0[2][2], B1[2][2];
    const char* cA = (const char*)g.A + (size_t)cur.pm * tstepA + (size_t)cur.pn * g.a_pn_bytes + (size_t)cur.kt0 * kstep; const char* cB = (const char*)g.Bt + (size_t)cur.pn * tstepB + (size_t)cur.kt0 * kstep;
    S.a_ready(cur);
    if constexpr (SP2) {
        PG8_STAGE(PG8_SB(0, 0), cB, voffB); PG8_STAGE(PG8_SB(0, 1), cB + hstepB, voffB); PG8_STAGE(PG8_SA(0, 0), cA, voffA); PG8_STAGE(PG8_SA(0, 1), cA + hstepA, voffA);
        if (wr == 1) PG8_BAR;
        PG8_WAIT_V(2); PG8_BAR;
        PG8_STAGE(PG8_SB(1, 0), cB + kstep, voffB); PG8_STAGE(PG8_SA(1, 0), cA + kstep, voffA); PG8_STAGE(PG8_SB(1, 1), cB + hstepB + kstep, voffB);
        PG8_WAIT_V(6); PG8_BAR;
    } else {
        PG8_STAGE(PG8_SB(0, 0), cB, voffB); PG8_STAGE(PG8_SA(0, 0), cA, voffA); PG8_STAGE(PG8_SB(0, 1), cB + hstepB, voffB); PG8_STAGE(PG8_SA(0, 1), cA + hstepA, voffA);
        if (wr == 1) PG8_BAR;
        PG8_WAIT_V(4); PG8_BAR;
        PG8_STAGE(PG8_SB(1, 0), cB + kstep, voffB); PG8_STAGE(PG8_SA(1, 0), cA + kstep, voffA); PG8_STAGE(PG8_SB(1, 1), cB + hstepB + kstep, voffB);
        PG8_WAIT_V(6); PG8_BAR;
    }
    for (;;) {
        const bool has_next = S.next(ui + 1, nxt);
        const char* nA = has_next ? (const char*)g.A + (size_t)nxt.pm * tstepA + (size_t)nxt.pn * g.a_pn_bytes + (size_t)nxt.kt0 * kstep : cA; const char* nB = has_next ? (const char*)g.Bt + (size_t)nxt.pn * tstepB + (size_t)nxt.kt0 * kstep : cB;
        const int ntu = cur.nt ? cur.nt : nt;
        for (int t = 0; t < ntu; t += 2) {
            const bool last = (t == ntu - 2);
            const char* a1 = cA + (size_t)(t + 1) * kstep;
            const char* a2 = last ? nA : cA + (size_t)(t + 2) * kstep; const char* b2 = last ? nB : cB + (size_t)(t + 2) * kstep;
            const char* a3 = a2 + kstep; const char* b3 = b2 + kstep;
            if (last && has_next) S.a_ready(nxt);
            if (last) E.prefetch_lds(cur, lds + STAGE_BYTES, wid, lane);
            if constexpr (SP2) {
            PG8_LDB(B0, 0, 0); PG8_LDB(B1, 0, 1); PG8_SCHED; PG8_LDA(At, 0, 0); PG8_STAGE(PG8_SA(1, 1), a1 + hstepA, voffA);
            PG8_WAIT_V(8); PG8_WAIT_L(0); PG8_BAR; PG8_MMA(0, 0, At, B0); PG8_MMA(0, 1, At, B1); PG8_BAR; PG8_SCHED;
            PG8_LDA(At, 0, 1); PG8_STAGE(PG8_SB(0, 0), b2, voffB); PG8_STAGE(PG8_SB(0, 1), b2 + hstepB, voffB); PG8_STAGE(PG8_SA(0, 0), a2, voffA);
            PG8_WAIT_V(8); PG8_WAIT_L(0); PG8_BAR; PG8_MMA(1, 0, At, B0); PG8_MMA(1, 1, At, B1); PG8_BAR; PG8_SCHED;
            PG8_LDB(B0, 1, 0); PG8_LDB(B1, 1, 1); PG8_SCHED; PG8_LDA(At, 1, 0); PG8_STAGE(PG8_SA(0, 1), a2 + hstepA, voffA);
            PG8_WAIT_V(8); PG8_WAIT_L(0); PG8_BAR; PG8_MMA(0, 0, At, B0); PG8_MMA(0, 1, At, B1); PG8_BAR; PG8_SCHED;
            PG8_LDA(At, 1, 1); PG8_STAGE(PG8_SB(1, 0), b3, voffB); PG8_STAGE(PG8_SB(1, 1), b3 + hstepB, voffB); PG8_STAGE(PG8_SA(1, 0), a3, voffA);
            PG8_WAIT_V(8); PG8_WAIT_L(0); PG8_BAR; PG8_MMA(1, 0, At, B0); PG8_MMA(1, 1, At, B1); PG8_BAR; PG8_SCHED;
            } else {
            PG8_LDB(B0, 0, 0); PG8_SCHED; PG8_LDA(At, 0, 0); PG8_STAGE(PG8_SA(1, 1), a1 + hstepA, voffA);
            PG8_WAIT_L(8); PG8_BAR; PG8_WAIT_L(0); PG8_MMA(0, 0, At, B0); PG8_BAR; PG8_SCHED;
            PG8_LDB(B1, 0, 1); PG8_STAGE(PG8_SB(0, 0), b2, voffB);
            PG8_BAR; PG8_WAIT_L(0); PG8_MMA(0, 1, At, B1); PG8_BAR;
            PG8_LDA(At, 0, 1); PG8_STAGE(PG8_SA(0, 0), a2, voffA);
            PG8_BAR; PG8_WAIT_L(0); PG8_MMA(1, 0, At, B0); PG8_BAR; PG8_SCHED;
            PG8_STAGE(PG8_SB(0, 1), b2 + hstepB, voffB);
            PG8_WAIT_V(6); PG8_BAR; PG8_MMA(1, 1, At, B1); PG8_BAR;
            PG8_LDB(B0, 1, 0); PG8_SCHED; PG8_LDA(At, 1, 0); PG8_STAGE(PG8_SA(0, 1), a2 + hstepA, voffA);
            PG8_WAIT_L(8); PG8_BAR; PG8_WAIT_L(0); PG8_MMA(0, 0, At, B0); PG8_BAR; PG8_SCHED;
            PG8_LDB(B1, 1, 1); PG8_STAGE(PG8_SB(1, 0), b3, voffB);
            PG8_BAR; PG8_WAIT_L(0); PG8_MMA(0, 1, At, B1); PG8_BAR;
            PG8_LDA(At, 1, 1); PG8_STAGE(PG8_SA(1, 0), a3, voffA);
            PG8_BAR; PG8_WAIT_L(0); PG8_MMA(1, 0, At, B0); PG8_BAR; PG8_SCHED;
            PG8_STAGE(PG8_SB(1, 1), b3 + hstepB, voffB);
            PG8_WAIT_V(6); PG8_BAR; PG8_MMA(1, 1, At, B1); PG8_BAR;
            }
        }
        if constexpr (ALIGN_EPI) { if (wr == 0) PG8_BAR; }
        if constexpr (!Epi::AFTER_DRAIN) { E(acc, cur, wr, wc, fr, fq, lds + STAGE_BYTES); S.done(cur); }
        if (!has_next) break;
#pragma unroll
        for (int a = 0; a < 2; ++a)
#pragma unroll
            for (int b = 0; b < 2; ++b)
#pragma unroll
                for (int m = 0; m < 4; ++m)
#pragma unroll
                    for (int n = 0; n < 2; ++n) acc[a][b][m][n] = (f32x4){0.f, 0.f, 0.f, 0.f};
        cur = nxt; cA = nA; cB = nB; ++ui;
        if constexpr (ALIGN_EPI) { if (wr == 1) PG8_BAR; }
    }
    PG8_WAIT_V(0);
    if constexpr (!ALIGN_EPI) { if (wr == 0) PG8_BAR; }
    PG8_BAR;
#undef PG8_SA
#undef PG8_SB
#undef PG8_STAGE
#undef PG8_LDA
#undef PG8_LDB
#undef PG8_MMA
#undef PG8_WAIT_V
#undef PG8_WAIT_L
#undef PG8_BAR
#undef PG8_SCHED
}
}
#define LAS __attribute__((address_space(3)))
typedef unsigned short bf16;
typedef float f32x4 __attribute__((ext_vector_type(4)));
typedef unsigned v4u __attribute__((ext_vector_type(4)));
typedef unsigned v2u __attribute__((ext_vector_type(2)));
typedef short bf16x8 __attribute__((ext_vector_type(8)));
constexpr int NWAVES = 8, NTHR = 512;
constexpr int DM = 2048, TP = 2064, RP = 8256, RS = 1024, R = 9280, MP = 9472, INW = 5128, PW = 5120, DFF = 5632, NCH = 33;
constexpr float EPS = 1e-6f;
constexpr int LDS_BYTES = 147456;
constexpr size_t MiB = 1u << 20;
constexpr size_t WS_WIN = 0;
constexpr size_t WS_WOUT = 20 * MiB;
constexpr size_t WS_WGU = 28 * MiB;
constexpr size_t WS_WD = 72 * MiB;
constexpr size_t WS_WP = 94 * MiB;
constexpr size_t WS_GATES = 95 * MiB;
constexpr size_t WS_SS1 = 96 * MiB;
constexpr size_t WS_SS2 = 96 * MiB + 65536;
constexpr size_t WS_NST = 232 * MiB;
constexpr size_t WS_MST = 98 * MiB;
constexpr size_t WS_CTL = 99 * MiB, CTL_BYTES = 65536;
constexpr size_t WS_XN = 100 * MiB;
constexpr size_t WS_P = 138 * MiB;
constexpr size_t WS_D = 232 * MiB;
constexpr size_t WS_H = 406 * MiB;
constexpr size_t WS_MIX = 252 * MiB;
constexpr size_t WS_X1 = 290 * MiB;
constexpr size_t WS_CT = WS_X1;
constexpr size_t WS_SLAB = 366 * MiB;
constexpr size_t WS_END = 508 * MiB;
static_assert(WS_H + (size_t)MP * DFF * 2 <= WS_END && WS_SLAB + (size_t)4 * 1280 * DM * 4 <= WS_H && WS_P + (size_t)MP * PW * 2 <= WS_D && WS_D + (size_t)MP * 1024 * 2 <= WS_MIX && WS_MIX + (size_t)MP * DM * 2 <= WS_X1 && WS_X1 + (size_t)MP * DM * 4 <= WS_END, "ws map");
constexpr size_t O_YP = 0, O_YS = 16777216, O_POOLP = 18874368, O_CP = 18935808, O_NP = 19984384, O_MP = 19988480, O_POOLS = 19988496, O_CS = 21954576, O_NS = 55509008, O_MS = 55640080, O_END = 55640592;

#define LDS_WAIT() asm volatile("s_waitcnt lgkmcnt(0)" ::: "memory")
#define LBAR() do { asm volatile("s_waitcnt lgkmcnt(0)" ::: "memory"); __builtin_amdgcn_s_barrier(); asm volatile("" ::: "memory"); } while (0)
__device__ __forceinline__ unsigned f2bf(float f) { unsigned u = __builtin_bit_cast(unsigned, f); return (u + 0x7fffu + ((u >> 16) & 1u)) >> 16; }
__device__ __forceinline__ unsigned pk2(float lo, float hi) { return pg8::cvt_pk_bf16(lo, hi); }
__device__ __forceinline__ float bf2f(unsigned short b) { return __builtin_bit_cast(float, (unsigned)b << 16); }
__device__ __forceinline__ float bflo(unsigned w) { return __builtin_bit_cast(float, w << 16); }
__device__ __forceinline__ float bfhi(unsigned w) { return __builtin_bit_cast(float, w & 0xffff0000u); }
template <int CTRL, int ROWMASK> __device__ __forceinline__ float dpp_f(float oldv, float v) {
    return __builtin_bit_cast(float, __builtin_amdgcn_update_dpp(__builtin_bit_cast(int, oldv), __builtin_bit_cast(int, v), CTRL, ROWMASK, 0xf, false));
}
__device__ __forceinline__ float scan_add_dpp(float v) {
    v += dpp_f<0x111, 0xf>(0.f, v); v += dpp_f<0x112, 0xf>(0.f, v); v += dpp_f<0x114, 0xf>(0.f, v); v += dpp_f<0x118, 0xf>(0.f, v);
    v += dpp_f<0x142, 0xa>(0.f, v);
    v += dpp_f<0x143, 0xc>(0.f, v);
    return v;
}
__device__ __forceinline__ float scan_max_dpp(float v) {
    const float ni = -INFINITY;
    v = fmaxf(v, dpp_f<0x111, 0xf>(ni, v)); v = fmaxf(v, dpp_f<0x112, 0xf>(ni, v)); v = fmaxf(v, dpp_f<0x114, 0xf>(ni, v)); v = fmaxf(v, dpp_f<0x118, 0xf>(ni, v));
    v = fmaxf(v, dpp_f<0x142, 0xa>(ni, v));
    v = fmaxf(v, dpp_f<0x143, 0xc>(ni, v));
    return v;
}
__device__ __forceinline__ float row16_sum_dpp(float v) {
    v += dpp_f<0x111, 0xf>(0.f, v); v += dpp_f<0x112, 0xf>(0.f, v); v += dpp_f<0x114, 0xf>(0.f, v); v += dpp_f<0x118, 0xf>(0.f, v); return v; }
__device__ __forceinline__ float row8_sum_dpp(float v) {
    v += dpp_f<0x111, 0xf>(0.f, v); v += dpp_f<0x112, 0xf>(0.f, v); v += dpp_f<0x114, 0xf>(0.f, v); return v; }
__device__ __forceinline__ float lane63(float v) { return __builtin_bit_cast(float, __builtin_amdgcn_readlane(__builtin_bit_cast(int, v), 63)); }
__device__ __forceinline__ float wave_sum(float v) { return lane63(scan_add_dpp(v)); }
__device__ __forceinline__ float logsigmoid(float x) { return x >= 0.f ? -log1pf(expf(-x)) : x - log1pf(expf(x)); }
__device__ __forceinline__ float sigmoidf(float x) { return __builtin_amdgcn_rcpf(1.0f + __expf(-x)); }

struct Ptrs;
typedef const __attribute__((address_space(4))) Ptrs* KP;
struct Ptrs {
    const float *xp, *xs, *spool, *sC, *sn, *sm, *meta, *nmix, *win, *bi, *bf, *wpool, *pscale, *gnorm, *wout, *nffn, *wgate, *wup, *wdown, *nfinal;
    float* out; unsigned char* ws;
};

#define XB_TMO      128
#define XB_XCNT(j)  (256  + 64 * (j))
#define XB_XSUB(j)  (1280 + 64 * (j))
#define XB_XGEN(j)  (2304 + 64 * (j))
#define XB_TOP      3328
#define XB_TOPGEN   3392
#define XCD_BAR_WORDS 3456
#define XB_SPIN_CAP (1u << 18)

__device__ __forceinline__ unsigned xb_ld(unsigned* p)              { return __hip_atomic_load(p, __ATOMIC_RELAXED, __HIP_MEMORY_SCOPE_AGENT); }
__device__ __forceinline__ unsigned xb_add(unsigned* p, unsigned v) { return __hip_atomic_fetch_add(p, v, __ATOMIC_RELAXED, __HIP_MEMORY_SCOPE_AGENT); }
__device__ __forceinline__ unsigned xb_xcc_id() { return (unsigned)__builtin_amdgcn_s_getreg((3 << 11) | 20) & 0xFu; }
#define XB_SPIN(cond, bar) do { unsigned _sp = 0; while (cond) { __builtin_amdgcn_s_sleep(1); \
    if ((++_sp & 255u) == 0u) { if (xb_ld(&(bar)[XB_TMO])) break; if (_sp > XB_SPIN_CAP) { atomicAdd(&(bar)[XB_TMO], 1u); break; } } } } while (0)

struct XcdBarrier {
    unsigned* bar; unsigned x;
    volatile LAS unsigned* st;
};

__device__ __forceinline__ XcdBarrier xcd_barrier_post(unsigned* bar, volatile LAS unsigned* st) {
    XcdBarrier b; b.bar = bar; b.x = xb_xcc_id(); b.st = st;
    if (threadIdx.x == 0) (void)xb_add(&bar[XB_XCNT(b.x)], 1u);
    return b;
}
__device__ __forceinline__ void xcd_barrier_complete(unsigned* bar, unsigned x, unsigned& nloc, unsigned& nx) {
    const unsigned G = gridDim.x * gridDim.y * gridDim.z;
    unsigned sum, cnt, mine, sp = 0u;
    for (;;) {
        sum = 0u; cnt = 0u; mine = 0u;
#pragma unroll
        for (unsigned j = 0; j < 16; ++j) { const unsigned c = xb_ld(&bar[XB_XCNT(j)]); sum += c; cnt += (c > 0u) ? 1u : 0u; mine = (j == x) ? c : mine; }
        if (sum == G) break;
        __builtin_amdgcn_s_sleep(1);
        if ((++sp & 255u) == 0u) { if (xb_ld(&bar[XB_TMO])) break; if (sp > XB_SPIN_CAP) { atomicAdd(&bar[XB_TMO], 1u); break; } }
    }
    nloc = mine > 0u ? mine : 1u; nx = cnt > 0u ? cnt : 1u;
}

__device__ __forceinline__ void xcd_barrier(const XcdBarrier& b) {
    asm volatile("s_waitcnt vmcnt(0)" ::: "memory");
    __syncthreads();
    if (threadIdx.x == 0) {
        unsigned* bar = b.bar;
        __builtin_amdgcn_s_waitcnt(0);
        unsigned nloc = b.st[0], nx = b.st[1];
        if (nloc == 0u) { xcd_barrier_complete(bar, b.x, nloc, nx); b.st[0] = nloc; b.st[1] = nx; }
        const unsigned old = xb_add(&bar[XB_XSUB(b.x)], 1u);
        const unsigned gen = old / nloc;
        if (old + 1u == (gen + 1u) * nloc) {
            __builtin_amdgcn_fence(__ATOMIC_RELEASE, "agent");
            asm volatile("s_waitcnt vmcnt(0)" ::: "memory");
            const unsigned og = xb_add(&bar[XB_TOP], 1u);
            const unsigned tg = og / nx;
            if (og + 1u == (tg + 1u) * nx) xb_add(&bar[XB_TOPGEN], 1u);
            else XB_SPIN(xb_ld(&bar[XB_TOPGEN]) == tg, bar);
            __builtin_amdgcn_fence(__ATOMIC_ACQUIRE, "agent");
            xb_add(&bar[XB_XGEN(b.x)], 1u);
            asm volatile("s_waitcnt vmcnt(0)" ::: "memory");
        } else {
            XB_SPIN(xb_ld(&bar[XB_XGEN(b.x)]) == gen, bar);
            __builtin_amdgcn_fence(__ATOMIC_ACQUIRE, "agent");
            asm volatile("s_waitcnt vmcnt(0)" ::: "memory");
        }
    }
    __syncthreads();
}

__device__ __forceinline__ void transpose_item(const float* W, int ldw, bf16* WT, int ldt, int k0, int n0, int drow0, const float* kscale, const float* nscale, LAS float* scr, int lane) {
    const float ns = nscale ? nscale[n0 + lane] : 1.f;
    const float* src = W + (size_t)k0 * ldw + n0 + lane;
    float v[64];
#pragma unroll
    for (int i = 0; i < 64; ++i) v[i] = __builtin_nontemporal_load(src + (size_t)i * ldw);
#pragma unroll
    for (int i = 0; i < 64; ++i) { float x = v[i]; if (kscale) x *= kscale[k0 + i]; scr[i * 65 + lane] = x * ns; }
    LDS_WAIT(); asm volatile("" ::: "memory");
    const int c = lane & 7;
#pragma unroll
    for (int j = 0; j < 8; ++j) { const int n = (lane >> 3) + 8 * j; const LAS float* s = scr + (8 * c) * 65 + n;
        v4u o; o.x = pk2(s[0 * 65], s[1 * 65]); o.y = pk2(s[2 * 65], s[3 * 65]); o.z = pk2(s[4 * 65], s[5 * 65]); o.w = pk2(s[6 * 65], s[7 * 65]);
        *(v4u*)(WT + (size_t)(drow0 + n) * ldt + k0 + 8 * c) = o; }
    LDS_WAIT(); asm volatile("" ::: "memory");
}
__device__ __forceinline__ void p0_prologue(KP p, LAS unsigned char* lds, int tid, int lane, int wave, int G, int part = 3) {
    unsigned char* ws = p->ws;
    bf16* Win_t = (bf16*)(ws + WS_WIN); bf16* Wout_t = (bf16*)(ws + WS_WOUT); bf16* Wgu_t = (bf16*)(ws + WS_WGU); bf16* Wd_t = (bf16*)(ws + WS_WD); bf16* Wp_t = (bf16*)(ws + WS_WP);
    float* GATES = (float*)(ws + WS_GATES); bf16* XN = (bf16*)(ws + WS_XN);
    const int gw = blockIdx.x * NWAVES + wave, NGW = G * NWAVES;
    for (int i = blockIdx.x * NTHR + tid; i < 2 * 16384; i += G * NTHR) ((float*)(ws + WS_SS1))[i] = 0.f;
    LAS float* GW = (LAS float*)lds;
    for (int k = tid; k < DM; k += NTHR) { const f32x4 a = *(const f32x4*)(p->win + (size_t)k * INW + 5120), b = *(const f32x4*)(p->win + (size_t)k * INW + 5124);
        GW[0 * DM + k] = a[0]; GW[1 * DM + k] = a[1]; GW[2 * DM + k] = a[2]; GW[3 * DM + k] = a[3]; GW[4 * DM + k] = b[0]; GW[5 * DM + k] = b[1]; GW[6 * DM + k] = b[2]; GW[7 * DM + k] = b[3]; }
    __syncthreads();
    pg8::RowMap rm{p->xp, p->xs, p->meta, nullptr, nullptr};
    f32x4 vn[8];
    if (gw < R) { const f32x4* xr = (const f32x4*)pg8::xrow_ptr(rm, gw) + lane;
#pragma unroll
        for (int j = 0; j < 8; ++j) vn[j] = xr[64 * j]; }
    if (part & 1) for (int r = gw; r < MP; r += NGW) {
        unsigned long long* o8 = (unsigned long long*)(XN + (size_t)r * DM) + lane;
        if (r >= R) {
#pragma unroll
            for (int j = 0; j < 8; ++j) o8[64 * j] = 0ull;
            continue; }
        f32x4 v[8]; float s = 0.f;
#pragma unroll
        for (int j = 0; j < 8; ++j) { v[j] = vn[j]; s += (v[j][0] * v[j][0] + v[j][1] * v[j][1]) + (v[j][2] * v[j][2] + v[j][3] * v[j][3]); }
        if (r + NGW < R) { const f32x4* xr = (const f32x4*)pg8::xrow_ptr(rm, r + NGW) + lane;
#pragma unroll
            for (int j = 0; j < 8; ++j) vn[j] = xr[64 * j]; }
        const float rstd = 1.0f / sqrtf(wave_sum(s) * (1.0f / DM) + EPS);
        float ga[8];
#pragma unroll
        for (int g = 0; g < 8; ++g) ga[g] = 0.f;
#pragma unroll
        for (int j = 0; j < 8; ++j) { const f32x4 w4 = ((const f32x4*)p->nmix)[64 * j + lane]; const f32x4 y = v[j] * rstd * w4;
            o8[64 * j] = (unsigned long long)pk2(y[0], y[1]) | ((unsigned long long)pk2(y[2], y[3]) << 32);
#pragma unroll
            for (int g = 0; g < 8; ++g) { const f32x4 gw4 = *(const LAS f32x4*)(GW + g * DM + (64 * j + lane) * 4); ga[g] += (y[0] * gw4[0] + y[1] * gw4[1]) + (y[2] * gw4[2] + y[3] * gw4[3]); } }
#pragma unroll
        for (int g = 0; g < 8; ++g) ga[g] = wave_sum(ga[g]);
        if (lane == 0) { *(f32x4*)(GATES + (size_t)r * 8) = (f32x4){ga[0], ga[1], ga[2], ga[3]}; *(f32x4*)(GATES + (size_t)r * 8 + 4) = (f32x4){ga[4], ga[5], ga[6], ga[7]}; }
    }
    __syncthreads();
    LAS float* scr = (LAS float*)(lds + wave * 16640);
    constexpr int I_IN = 32 * 80, I_OUT = 32 * 32, I_G = 32 * 88, I_D = 88 * 32, I_P = 4 * 16;
    constexpr int NITEMS = I_IN + I_OUT + 2 * I_G + I_D; (void)I_P;
    if (part & 2) for (int it = gw; it < NITEMS; it += NGW) {
        int r = it;
        if (r < I_IN) { const int kb = r / 80, nb = r % 80; transpose_item(p->win, INW, Win_t, DM, 64 * kb, 64 * nb, 64 * nb, nullptr, nullptr, scr, lane); continue; } r -= I_IN;
        if (r < I_OUT) { const int kb = r / 32, nb = r % 32; transpose_item(p->wout, DM, Wout_t, DM, 64 * kb, 64 * nb, 64 * nb, nullptr, nullptr, scr, lane); continue; } r -= I_OUT;
        if (r < I_G) { const int kb = r / 88, nb = r % 88, n0 = 64 * nb; transpose_item(p->wgate, DFF, Wgu_t, DM, 64 * kb, n0, (n0 >> 7) * 256 + (n0 & 127), p->nffn, nullptr, scr, lane); continue; } r -= I_G;
        if (r < I_G) { const int kb = r / 88, nb = r % 88, n0 = 64 * nb; transpose_item(p->wup, DFF, Wgu_t, DM, 64 * kb, n0, (n0 >> 7) * 256 + 128 + (n0 & 127), p->nffn, nullptr, scr, lane); continue; } r -= I_G;
        if (r < I_D) { const int kb = r / 32, nb = r % 32; transpose_item(p->wdown, DM, Wd_t, DFF, 64 * kb, 64 * nb, 64 * nb, nullptr, nullptr, scr, lane); continue; } r -= I_D;
        { }
    }
    if (part & 2) for (int i = (blockIdx.x * NTHR + tid) * 4; i < 4 * 65536; i += G * NTHR * 4) { const f32x4 w4 = *(const f32x4*)(p->wpool + i); const f32x4 s4 = *(const f32x4*)(p->pscale + (i >> 16) * 256 + (i & 255));
        v2u o; o.x = pk2(w4[0] * s4[0], w4[1] * s4[1]); o.y = pk2(w4[2] * s4[2], w4[3] * s4[3]); *(v2u*)(Wp_t + i) = o; }
}

__device__ __forceinline__ float scan_add(float v, int) { return scan_add_dpp(v); }
__device__ __forceinline__ float scan_max(float v, int) { return scan_max_dpp(v); }
struct GateScan { float a, b, mt, g, m_new; };
__device__ __forceinline__ GateScan gate_scan(float gi, float gf, float bi, float bfv, bool valid, float m_c, int lane) {
    GateScan s;
    const float lf = valid ? logsigmoid(gf + bfv) : 0.f;
    s.b = scan_add(lf, lane);
    s.a = valid ? (gi + bi) - s.b : -INFINITY;
    const float cm = scan_max(s.a, lane);
    s.mt = s.b + fmaxf(m_c, cm);
    s.g = lane63(s.b);
    const float amax = lane63(cm);
    s.m_new = s.g + fmaxf(m_c, amax);
    return s;
}

typedef short s16x4 __attribute__((ext_vector_type(4)));
#define TR_READ(dst, addr, off) asm volatile("ds_read_b64_tr_b16 %0, %1 offset:%2" : "=&v"(dst) : "v"(addr), "i"(off) : "memory")
__device__ __forceinline__ bf16x8 cat8(s16x4 lo, s16x4 hi) { return __builtin_shufflevector(lo, hi, 0, 1, 2, 3, 4, 5, 6, 7); }

__device__ __forceinline__ void chain_unit(KP p, LAS unsigned char* lds, int tid, int lane, int wave, int bh, int sl) {
    const int b = bh >> 2, h = bh & 3;
    const bf16* P = (const bf16*)(p->ws + WS_P); const float* GATES = (const float*)(p->ws + WS_GATES);
    bf16* CT = (bf16*)(p->ws + WS_CT); float* NST = (float*)(p->ws + WS_NST); float* MST = (float*)(p->ws + WS_MST);
    constexpr int KSTR = 264, VSTR = 40, KBUF = 64 * KSTR * 2, VBUF = 64 * VSTR * 2;
    LAS unsigned char* Kb = lds;
    LAS unsigned char* Vb = lds + 2 * KBUF;
    LAS float* wtok = (LAS float*)(lds + 2 * KBUF + 2 * VBUF);
    LAS float* gL = wtok + 2112;
    LAS float* amL = gL + 40;
    LAS float* mch = amL + 40;
    LAS float* dec = mch + 40;
    const float bi = p->bi[h], bfv = p->bf[h];
    const int i16 = lane & 15, kq = lane >> 4;
    { float gi5[5], gf5[5];
#pragma unroll
      for (int k = 0; k < 5; ++k) { const int c = wave + 8 * k; const int L = c == 0 ? 16 : 64, t0 = c == 0 ? 0 : 16 + 64 * (c - 1); gi5[k] = 0.f; gf5[k] = 0.f;
          if (c < NCH && lane < L) { gi5[k] = GATES[(size_t)(b * TP + t0 + lane) * 8 + h]; gf5[k] = GATES[(size_t)(b * TP + t0 + lane) * 8 + 4 + h]; } }
#pragma unroll
      for (int k = 0; k < 5; ++k) { const int c = wave + 8 * k;
          if (c < NCH) { const int L = c == 0 ? 16 : 64, t0 = c == 0 ? 0 : 16 + 64 * (c - 1); const bool valid = lane < L;
              const float lf = valid ? logsigmoid(gf5[k] + bfv) : 0.f; const float bsum = scan_add(lf, lane); const float av = valid ? (gi5[k] + bi) - bsum : -INFINITY; const float cm = scan_max(av, lane);
              if (valid) wtok[t0 + lane] = av;
              if (lane == 63) { gL[c] = bsum; amL[c] = cm; } } } }
    LBAR();
    if (wave == 0) {
        const float gme = lane < NCH ? gL[lane] : 0.f, ame = lane < NCH ? amL[lane] : -INFINITY;
        float m = 0.f, m_at = 0.f, m_nx = 0.f;
#pragma unroll
        for (int c = 0; c < NCH; ++c) { const float g = __builtin_bit_cast(float, __builtin_amdgcn_readlane(__builtin_bit_cast(int, gme), c)), am = __builtin_bit_cast(float, __builtin_amdgcn_readlane(__builtin_bit_cast(int, ame), c));
            const float mn = g + fmaxf(m, am); if (lane == c) { m_at = m; m_nx = mn; } m = mn; }
        if (lane < NCH) { mch[lane] = m_at; dec[lane] = __expf(m_at + gme - m_nx); }
        if (lane == 0) mch[NCH] = m; }
    LBAR();
    for (int t = tid; t < TP; t += NTHR) { const int c = t < 16 ? 0 : 1 + ((t - 16) >> 6); wtok[t] = __expf(wtok[t] + gL[c] - mch[c + 1]) * 0.0625f; }
    if (sl == 0 && tid >= 1 && tid <= NCH) { if (tid < NCH) MST[bh * 34 + tid] = mch[tid]; else p->out[O_MP + bh] = mch[NCH]; }
    if (tid >= 2064 - 16 && tid < 2112) {}
    LBAR();
    float nval = 0.f;
    f32x4 acc[2][2];
#pragma unroll
    for (int a2 = 0; a2 < 2; ++a2)
#pragma unroll
        for (int c2 = 0; c2 < 2; ++c2) acc[a2][c2] = (f32x4){0.f, 0.f, 0.f, 0.f};
    v4u kA[4], kB[4]; v4u vA = (v4u){0u, 0u, 0u, 0u}, vB = vA;
#define CHAIN_ISSUE(cc, kreg, vreg) do { const int L_ = (cc) == 0 ? 16 : 64; const int r0_ = b * TP + ((cc) == 0 ? 0 : 16 + 64 * ((cc) - 1)); \
        _Pragma("unroll") for (int pp = 0; pp < 4; ++pp) { const int q_ = tid + 512 * pp, s_ = q_ >> 5, ch_ = q_ & 31; \
            kreg[pp] = s_ < L_ ? *(const v4u*)(P + (size_t)(r0_ + s_) * PW + 2048 + h * 256 + ch_ * 8) : (v4u){0u, 0u, 0u, 0u}; } \
        if (tid < 256) { const int s_ = tid >> 2, ch_ = tid & 3; vreg = s_ < L_ ? *(const v4u*)(P + (size_t)(r0_ + s_) * PW + 3072 + h * 256 + sl * 32 + ch_ * 8) : (v4u){0u, 0u, 0u, 0u}; } } while (0)
#define CHAIN_WRITE(cc, bufi, kreg, vreg) do { const int t0_ = (cc) == 0 ? 0 : 16 + 64 * ((cc) - 1); \
        _Pragma("unroll") for (int pp = 0; pp < 4; ++pp) { const int q_ = tid + 512 * pp, s_ = q_ >> 5, ch_ = q_ & 31; *(LAS v4u*)(Kb + (bufi) * KBUF + (s_ * KSTR + ch_ * 8) * 2) = kreg[pp]; } \
        if (tid < 256) { const int s_ = tid >> 2, ch_ = tid & 3; const float w_ = wtok[t0_ + s_]; v4u o_; \
            o_.x = pk2(bflo(vreg.x) * w_, bfhi(vreg.x) * w_); o_.y = pk2(bflo(vreg.y) * w_, bfhi(vreg.y) * w_); o_.z = pk2(bflo(vreg.z) * w_, bfhi(vreg.z) * w_); o_.w = pk2(bflo(vreg.w) * w_, bfhi(vreg.w) * w_); \
            *(LAS v4u*)(Vb + (bufi) * VBUF + (s_ * VSTR + ch_ * 8) * 2) = o_; } } while (0)
    CHAIN_ISSUE(0, kA, vA);
    CHAIN_WRITE(0, 0, kA, vA);
    CHAIN_ISSUE(1, kB, vB);
    CHAIN_ISSUE(2, kA, vA);
    LBAR();
    const int q4 = i16 >> 2, p4 = lane & 3;
    const unsigned aK0 = (unsigned)(size_t)Kb + (unsigned)(((8 * kq + q4) * KSTR + 32 * wave + 4 * p4) * 2);
    const unsigned aV0 = (unsigned)(size_t)Vb + (unsigned)(((8 * kq + q4) * VSTR + 4 * p4) * 2);
    const int ndk = tid & 31, nseg = tid >> 5;
#define CHAIN_STEP(c_, KR, VR) do { const int c = (c_); \
        const int buf = c & 1, t0 = c == 0 ? 0 : 16 + 64 * (c - 1); \
        const float decay = dec[c]; \
        const unsigned aK = aK0 + buf * KBUF, aV = aV0 + buf * VBUF; \
        s16x4 ra[2][2][2], rb[2][2][2]; \
        TR_READ(ra[0][0][0], aK, 0); TR_READ(ra[0][0][1], aK, 4 * KSTR * 2); TR_READ(ra[0][1][0], aK, 32); TR_READ(ra[0][1][1], aK, 4 * KSTR * 2 + 32); \
        TR_READ(rb[0][0][0], aV, 0); TR_READ(rb[0][0][1], aV, 4 * VSTR * 2); TR_READ(rb[0][1][0], aV, 32); TR_READ(rb[0][1][1], aV, 4 * VSTR * 2 + 32); \
        TR_READ(ra[1][0][0], aK, 32 * KSTR * 2); TR_READ(ra[1][0][1], aK, 36 * KSTR * 2); TR_READ(ra[1][1][0], aK, 32 * KSTR * 2 + 32); TR_READ(ra[1][1][1], aK, 36 * KSTR * 2 + 32); \
        TR_READ(rb[1][0][0], aV, 32 * VSTR * 2); TR_READ(rb[1][0][1], aV, 36 * VSTR * 2); TR_READ(rb[1][1][0], aV, 32 * VSTR * 2 + 32); TR_READ(rb[1][1][1], aV, 36 * VSTR * 2 + 32); \
        float ns = 0.f; \
        { const LAS unsigned short* kk = (const LAS unsigned short*)(Kb + buf * KBUF) + (4 * nseg) * KSTR + 32 * sl + ndk; \
_Pragma("unroll")           for (int e = 0; e < 4; ++e) ns += wtok[t0 + 4 * nseg + e] * bf2f(kk[e * KSTR]); } \
_Pragma("unroll")         for (int a2 = 0; a2 < 2; ++a2) \
_Pragma("unroll")             for (int c2 = 0; c2 < 2; ++c2) acc[a2][c2] = acc[a2][c2] * decay; \
        asm volatile("s_waitcnt lgkmcnt(0)" : "+v"(ra[0][0][0]), "+v"(ra[0][0][1]), "+v"(ra[0][1][0]), "+v"(ra[0][1][1]), "+v"(ra[1][0][0]), "+v"(ra[1][0][1]), "+v"(ra[1][1][0]), "+v"(ra[1][1][1]), \
                     "+v"(rb[0][0][0]), "+v"(rb[0][0][1]), "+v"(rb[0][1][0]), "+v"(rb[0][1][1]), "+v"(rb[1][0][0]), "+v"(rb[1][0][1]), "+v"(rb[1][1][0]), "+v"(rb[1][1][1]) :: "memory"); \
_Pragma("unroll")         for (int ks = 0; ks < 2; ++ks) \
_Pragma("unroll")             for (int mt = 0; mt < 2; ++mt) \
_Pragma("unroll")                 for (int nt = 0; nt < 2; ++nt) acc[mt][nt] = __builtin_amdgcn_mfma_f32_16x16x32_bf16(cat8(ra[ks][mt][0], ra[ks][mt][1]), cat8(rb[ks][nt][0], rb[ks][nt][1]), acc[mt][nt], 0, 0, 0); \
        nval = decay * nval + ns; \
        if (c + 1 < NCH) { CHAIN_WRITE(c + 1, buf ^ 1, KR, VR); if (c + 3 < NCH) CHAIN_ISSUE(c + 3, KR, VR); } \
        if (c + 1 < NCH) { \
            bf16* ct = CT + (size_t)(bh * NCH + c + 1) * 65536; \
_Pragma("unroll")             for (int mt = 0; mt < 2; ++mt) \
_Pragma("unroll")                 for (int nt = 0; nt < 2; ++nt) { const int dv = sl * 32 + 16 * nt + i16, dk = 32 * wave + 16 * mt + 4 * kq; const f32x4 v = acc[mt][nt]; \
                    v2u o; o.x = pk2(v[0], v[1]); o.y = pk2(v[2], v[3]); *(v2u*)(ct + (size_t)dv * 256 + dk) = o; } \
            NST[((size_t)(bh * 34 + c + 1) * 256 + 32 * sl + ndk) * 16 + nseg] = nval; \
        } \
        LBAR(); \
    } while (0)
    for (int cc = 0; cc + 1 < NCH; cc += 2) { CHAIN_STEP(cc, kB, vB); CHAIN_STEP(cc + 1, kA, vA); }
    CHAIN_STEP(NCH - 1, kB, vB);
#undef CHAIN_STEP
#undef CHAIN_ISSUE
#undef CHAIN_WRITE
    float* Cp = p->out + O_CP + (size_t)bh * 65536;
#pragma unroll
    for (int mt = 0; mt < 2; ++mt)
#pragma unroll
        for (int nt = 0; nt < 2; ++nt) { const int dv = sl * 32 + 16 * nt + i16, dk = 32 * wave + 16 * mt + 4 * kq;
#pragma unroll
            for (int j = 0; j < 4; ++j) Cp[(size_t)(dk + j) * 256 + dv] = acc[mt][nt][j]; }
    { LAS float* nf = (LAS float*)Kb; nf[ndk * 16 + nseg] = nval; LBAR();
      if (tid < 32) { float t = 0.f;
#pragma unroll
          for (int e = 0; e < 16; ++e) t += nf[tid * 16 + e];
          p->out[O_NP + (size_t)bh * 256 + 32 * sl + tid] = t; } }
    LBAR();
}

struct SampPre { v2u q2, k2, v2, o2; f32x4 n4, gn; float sn, m0, gi, gf; };
__device__ __forceinline__ void samp_load(KP p, int tid, int lane, int wave, int su, SampPre& r) {
    const int sb = su >> 2, h = su & 3, row0 = RP + sb * 8;
    const bf16* P = (const bf16*)(p->ws + WS_P); const float* GATES = (const float*)(p->ws + WS_GATES);
    const bf16* src = P + (size_t)(row0 + wave) * PW + h * 256 + 4 * lane;
    r.q2 = *(const v2u*)(src + 1024); r.k2 = *(const v2u*)(src + 2048); r.v2 = *(const v2u*)(src + 3072); r.o2 = *(const v2u*)(src + 4096);
    r.n4 = *(const f32x4*)(p->sn + (size_t)su * 256 + 4 * lane); r.gn = *(const f32x4*)(p->gnorm + h * 256 + 4 * lane);
    r.sn = tid < 256 ? p->sn[(size_t)su * 256 + tid] : 0.f; r.m0 = p->sm[su];
    r.gi = 0.f; r.gf = 0.f; if (wave == 0 && lane < 8) { r.gi = GATES[(size_t)(row0 + lane) * 8 + h]; r.gf = GATES[(size_t)(row0 + lane) * 8 + 4 + h]; }
}
template <bool DO_H, bool DO_UPD>
__device__ __forceinline__ void sample_unit(KP p, LAS unsigned char* lds, int tid, int lane, int wave, int su, const SampPre& pre) {
    const int sb = su >> 2, h = su & 3, row0 = RP + sb * 8;
    const bf16* P = (const bf16*)(p->ws + WS_P); const float* GATES = (const float*)(p->ws + WS_GATES); bf16* MIX = (bf16*)(p->ws + WS_MIX);
    LAS float* qT = (LAS float*)lds;
    LAS float* kT = (LAS float*)(lds + 8192);
    LAS float* kwT = (LAS float*)(lds + 16384);
    LAS float* vS = (LAS float*)(lds + 24576);
    LAS float* sc = (LAS float*)(lds + 32768);
    LAS float* red = (LAS float*)(lds + 36864);
    const float m0 = pre.m0;
    const int s_ld = wave;
    const v2u q2 = pre.q2, k2 = pre.k2, v2 = pre.v2; const v2u o2e = pre.o2; const f32x4 n4e = pre.n4, gne = pre.gn; const float sne = pre.sn;
    if (wave == 0) {
        const float gi = pre.gi, gf = pre.gf;
        const GateScan gs = gate_scan(gi, gf, p->bi[h], p->bf[h], lane < 8, m0, lane);
        if (lane < 8) { sc[lane] = gs.a; sc[8 + lane] = gs.b - gs.mt; sc[16 + lane] = __expf(m0 + gs.b - gs.mt); sc[24 + lane] = __expf(-gs.mt); sc[32 + lane] = __expf(gs.a + gs.g - gs.m_new); }
        if (lane == 0) { sc[40] = __expf(m0 + gs.g - gs.m_new); sc[41] = gs.m_new; }
    }
    if constexpr (DO_H) {
      const float qv[4] = {bflo(q2.x), bfhi(q2.x), bflo(q2.y), bfhi(q2.y)}; const float kv[4] = {bflo(k2.x), bfhi(k2.x), bflo(k2.y), bfhi(k2.y)};
#pragma unroll
      for (int e = 0; e < 4; ++e) { const int dk = 4 * lane + e; qT[dk * 8 + s_ld] = qv[e]; }
      *(LAS f32x4*)(kT + s_ld * 256 + 4 * lane) = (f32x4){kv[0] * 0.0625f, kv[1] * 0.0625f, kv[2] * 0.0625f, kv[3] * 0.0625f};
      *(LAS f32x4*)(vS + s_ld * 256 + 4 * lane) = (f32x4){bflo(v2.x), bfhi(v2.x), bflo(v2.y), bfhi(v2.y)};
      LBAR();
    } else {
      LBAR();
      const float ws = sc[32 + s_ld]; const float kv[4] = {bflo(k2.x), bfhi(k2.x), bflo(k2.y), bfhi(k2.y)};
#pragma unroll
      for (int e = 0; e < 4; ++e) { const int dk = 4 * lane + e; kwT[dk * 8 + s_ld] = kv[e] * 0.0625f * ws; }
      *(LAS f32x4*)(vS + s_ld * 256 + 4 * lane) = (f32x4){bflo(v2.x), bfhi(v2.x), bflo(v2.y), bfhi(v2.y)};
      LBAR();
    }
    const float decay = sc[40];
    const int t = wave;
    float St[8]; float qn0 = 0.f;
#pragma unroll
    for (int s = 0; s < 8; ++s) St[s] = 0.f;
    if constexpr (DO_H) { float qd[4];
#pragma unroll
      for (int e = 0; e < 4; ++e) qd[e] = 0.f;
      qd[0] = bflo(q2.x); qd[1] = bfhi(q2.x); qd[2] = bflo(q2.y); qd[3] = bfhi(q2.y);
      const f32x4 n4 = n4e;
      qn0 = wave_sum((qd[0] * n4[0] + qd[1] * n4[1]) + (qd[2] * n4[2] + qd[3] * n4[3]));
      const float bm_t = sc[8 + t];
#pragma unroll
      for (int s = 0; s < 8; ++s) { float d = 0.f;
          { const f32x4 k4 = *(const LAS f32x4*)(kT + s * 256 + 4 * lane); d = (qd[0] * k4[0] + qd[1] * k4[1]) + (qd[2] * k4[2] + qd[3] * k4[3]); }
          d = wave_sum(d); St[s] = s <= t ? d * __expf(sc[s] + bm_t) : 0.f; } }
    { const int grp = wave, dv4 = 4 * lane;
      f32x4 vr[8], ac[8];
#pragma unroll
      for (int s = 0; s < 8; ++s) { vr[s] = *(const LAS f32x4*)(vS + s * 256 + dv4); ac[s] = (f32x4){0.f, 0.f, 0.f, 0.f}; }
      const float* C0 = p->sC + (size_t)su * 65536; float* C1 = p->out + O_CS + (size_t)su * 65536;
      f32x4 cb[2][8];
#pragma unroll
      for (int u = 0; u < 8; ++u) cb[0][u] = __builtin_nontemporal_load((const f32x4*)(C0 + (size_t)(grp + 8 * u) * 256 + dv4));
#pragma unroll
      for (int bt = 0; bt < 4; ++bt) { const int i0 = 8 * bt;
          if (bt < 3) {
#pragma unroll
              for (int u = 0; u < 8; ++u) cb[(bt + 1) & 1][u] = __builtin_nontemporal_load((const f32x4*)(C0 + (size_t)(grp + 8 * (i0 + 8 + u)) * 256 + dv4)); }
#pragma unroll
          for (int u = 0; u < 8; ++u) { const int dk = grp + 8 * (i0 + u); const f32x4 c4 = cb[bt & 1][u];
              const f32x4 qa = *(const LAS f32x4*)(qT + dk * 8), qb = *(const LAS f32x4*)(qT + dk * 8 + 4), ka = *(const LAS f32x4*)(kwT + dk * 8), kb = *(const LAS f32x4*)(kwT + dk * 8 + 4);
              if constexpr (DO_H) { ac[0] += qa[0] * c4; ac[1] += qa[1] * c4; ac[2] += qa[2] * c4; ac[3] += qa[3] * c4; ac[4] += qb[0] * c4; ac[5] += qb[1] * c4; ac[6] += qb[2] * c4; ac[7] += qb[3] * c4; }
              if constexpr (DO_UPD) { f32x4 cn = decay * c4; cn += ka[0] * vr[0]; cn += ka[1] * vr[1]; cn += ka[2] * vr[2]; cn += ka[3] * vr[3]; cn += kb[0] * vr[4]; cn += kb[1] * vr[5]; cn += kb[2] * vr[6]; cn += kb[3] * vr[7];
                  __builtin_nontemporal_store(cn, (f32x4*)(C1 + (size_t)dk * 256 + dv4)); } } }
      if constexpr (DO_H) {
#pragma unroll
          for (int s = 0; s < 8; ++s) *(LAS f32x4*)(red + (size_t)(grp * 8 + s) * 256 + dv4) = ac[s]; } }
    LBAR();
    if constexpr (DO_H) { const int dv4 = 4 * lane; f32x4 qc = (f32x4){0.f, 0.f, 0.f, 0.f};
#pragma unroll
      for (int g = 0; g < 8; ++g) qc += *(const LAS f32x4*)(red + (size_t)(g * 8 + t) * 256 + dv4);
      f32x4 sv = (f32x4){0.f, 0.f, 0.f, 0.f}; float ssum = 0.f;
#pragma unroll
      for (int s = 0; s < 8; ++s) { sv += St[s] * *(const LAS f32x4*)(vS + s * 256 + dv4); ssum += St[s]; }
      const float inter = sc[16 + t], em = sc[24 + t];
      const float qn = ssum + inter * qn0, den = fmaxf(fabsf(qn), em);
      const f32x4 hh = (sv + inter * qc) * __builtin_amdgcn_rcpf(den);
      const float ssq = wave_sum((hh[0] * hh[0] + hh[1] * hh[1]) + (hh[2] * hh[2] + hh[3] * hh[3]));
      const float rstd = 1.0f / sqrtf(ssq * (1.0f / 256.0f) + EPS);
      const v2u o2 = o2e; const f32x4 gn = gne;
      v2u y; y.x = pk2(hh[0] * rstd * gn[0] * sigmoidf(bflo(o2.x)), hh[1] * rstd * gn[1] * sigmoidf(bfhi(o2.x))); y.y = pk2(hh[2] * rstd * gn[2] * sigmoidf(bflo(o2.y)), hh[3] * rstd * gn[3] * sigmoidf(bfhi(o2.y)));
      *(v2u*)(MIX + (size_t)(row0 + t) * DM + 1024 + h * 256 + dv4) = y; }
    if constexpr (DO_H) {
    if (tid < 256) { float s = decay * sne;
#pragma unroll
        for (int e = 0; e < 8; ++e) s += kT[e * 256 + tid] * sc[32 + e];
        p->out[O_NS + (size_t)su * 256 + tid] = s; }
    if (tid == 0) p->out[O_MS + su] = sc[41]; }
    LBAR();
}

__device__ __forceinline__ void upd2_unit(KP p, LAS unsigned char* lds, int tid, int lane, int wave, int u) {
    const int sb = u >> 1, h0 = (u & 1) * 2, row0 = RP + sb * 8;
    const bf16* P = (const bf16*)(p->ws + WS_P); const float* GATES = (const float*)(p->ws + WS_GATES);
    LAS float* kwT = (LAS float*)lds;
    LAS float* vS = (LAS float*)(lds + 16384);
    LAS float* sc = (LAS float*)(lds + 32768);
    v2u k2[2], v2[2];
#pragma unroll
    for (int hh = 0; hh < 2; ++hh) { k2[hh] = *(const v2u*)(P + (size_t)(row0 + wave) * PW + 2048 + (h0 + hh) * 256 + 4 * lane); v2[hh] = *(const v2u*)(P + (size_t)(row0 + wave) * PW + 3072 + (h0 + hh) * 256 + 4 * lane); }
    if (wave < 2) { const int h = h0 + wave; const float m0 = p->sm[sb * 4 + h];
        float gi = 0.f, gf = 0.f; if (lane < 8) { gi = GATES[(size_t)(row0 + lane) * 8 + h]; gf = GATES[(size_t)(row0 + lane) * 8 + 4 + h]; }
        const GateScan gs = gate_scan(gi, gf, p->bi[h], p->bf[h], lane < 8, m0, lane);
        if (lane < 8) sc[wave * 64 + 32 + lane] = __expf(gs.a + gs.g - gs.m_new);
        if (lane == 0) sc[wave * 64 + 40] = __expf(m0 + gs.g - gs.m_new); }
    LBAR();
#pragma unroll
    for (int hh = 0; hh < 2; ++hh) { const float ws = sc[hh * 64 + 32 + wave] * 0.0625f; const float kv[4] = {bflo(k2[hh].x), bfhi(k2[hh].x), bflo(k2[hh].y), bfhi(k2[hh].y)};
#pragma unroll
        for (int e = 0; e < 4; ++e) kwT[hh * 2048 + (4 * lane + e) * 8 + wave] = kv[e] * ws;
        *(LAS f32x4*)(vS + hh * 2048 + wave * 256 + 4 * lane) = (f32x4){bflo(v2[hh].x), bfhi(v2[hh].x), bflo(v2[hh].y), bfhi(v2[hh].y)}; }
    LBAR();
    const int grp = wave, dv4 = 4 * lane;
#pragma unroll 1
    for (int hh = 0; hh < 2; ++hh) {
        const float decay = sc[hh * 64 + 40];
        f32x4 vr[8];
#pragma unroll
        for (int s = 0; s < 8; ++s) vr[s] = *(const LAS f32x4*)(vS + hh * 2048 + s * 256 + dv4);
        const float* C0 = p->sC + (size_t)(sb * 4 + h0 + hh) * 65536; float* C1 = p->out + O_CS + (size_t)(sb * 4 + h0 + hh) * 65536;
        const LAS float* kw = kwT + hh * 2048;
        f32x4 cb[2][8];
#pragma unroll
        for (int q = 0; q < 8; ++q) cb[0][q] = __builtin_nontemporal_load((const f32x4*)(C0 + (size_t)(grp + 8 * q) * 256 + dv4));
#pragma unroll
        for (int bt = 0; bt < 4; ++bt) { const int i0 = 8 * bt;
            if (bt < 3) {
#pragma unroll
                for (int q = 0; q < 8; ++q) cb[(bt + 1) & 1][q] = __builtin_nontemporal_load((const f32x4*)(C0 + (size_t)(grp + 8 * (i0 + 8 + q)) * 256 + dv4)); }
#pragma unroll
            for (int q = 0; q < 8; ++q) { const int dk = grp + 8 * (i0 + q); const f32x4 c4 = cb[bt & 1][q];
                const f32x4 ka = *(const LAS f32x4*)(kw + dk * 8), kb = *(const LAS f32x4*)(kw + dk * 8 + 4);
                f32x4 cn = decay * c4; cn += ka[0] * vr[0]; cn += ka[1] * vr[1]; cn += ka[2] * vr[2]; cn += ka[3] * vr[3]; cn += kb[0] * vr[4]; cn += kb[1] * vr[5]; cn += kb[2] * vr[6]; cn += kb[3] * vr[7];
                __builtin_nontemporal_store(cn, (f32x4*)(C1 + (size_t)dk * 256 + dv4)); } } }
    LBAR();
}

__device__ __forceinline__ void prompt_out_unit(KP p, LAS unsigned char* lds, int tid, int lane, int wave, int bh, int c) {
    const int b = bh >> 2, h = bh & 3, L = c == 0 ? 16 : 64, row0 = b * TP + (c == 0 ? 0 : 16 + 64 * (c - 1));
    const bf16* P = (const bf16*)(p->ws + WS_P); const float* GATES = (const float*)(p->ws + WS_GATES); bf16* MIX = (bf16*)(p->ws + WS_MIX);
    const bf16* CT = (const bf16*)(p->ws + WS_CT); const float* NST = (const float*)(p->ws + WS_NST); const float* MST = (const float*)(p->ws + WS_MST);
    constexpr int QSTR = 264;
    LAS unsigned short* Qs = (LAS unsigned short*)lds;
    LAS unsigned short* Ks = (LAS unsigned short*)(lds + 33792);
    LAS unsigned short* Vs = (LAS unsigned short*)(lds + 67584);
    LAS unsigned short* Ss = (LAS unsigned short*)(lds + 101376);
    LAS float* nL = (LAS float*)(lds + 110592);
    LAS float* aL = (LAS float*)(lds + 111616);
    LAS float* bmL = aL + 64;
    LAS float* interL = aL + 128;
    LAS float* emL = aL + 192;
    LAS float* rsum = (LAS float*)(lds + 112640);
    LAS float* qdn = (LAS float*)(lds + 113152);
    LAS float* hs = (LAS float*)(lds + 113408);
    LAS float* Hs = (LAS float*)lds;
    const int i16 = lane & 15, kq = lane >> 4;
    const float m_c = c ? MST[bh * 34 + c] : 0.f;
    const int dv0 = 32 * wave;
#pragma unroll 2
    for (int pp = 0; pp < 4; ++pp) { const int q = tid + 512 * pp, s = q >> 5, ch = q & 31; const bf16* src = P + (size_t)(row0 + s) * PW + h * 256 + ch * 8;
        v4u qv = (v4u){0u, 0u, 0u, 0u}, kv = qv, vv = qv;
        if (s < L) { qv = *(const v4u*)(src + 1024); kv = *(const v4u*)(src + 2048); vv = *(const v4u*)(src + 3072); }
        *(LAS v4u*)(Qs + s * QSTR + ch * 8) = qv; *(LAS v4u*)(Ks + s * QSTR + ch * 8) = kv; *(LAS v4u*)(Vs + s * QSTR + ch * 8) = vv; }
    asm volatile("" ::: "memory");
    bf16x8 bc[4][2];
    const bf16* ct = CT + ((size_t)(bh * NCH + c) * 256 + dv0) * 256;
    if (c > 0) {
#pragma unroll
        for (int ks = 0; ks < 4; ++ks)
#pragma unroll
            for (int nt = 0; nt < 2; ++nt) bc[ks][nt] = *(const bf16x8*)(ct + (size_t)(16 * nt + i16) * 256 + 32 * ks + 8 * kq); }
    if (tid < 256) { float nv = 0.f; if (c) { const f32x4* np4 = (const f32x4*)(NST + ((size_t)(bh * 34 + c) * 256 + tid) * 16); const f32x4 a0 = np4[0], a1 = np4[1], a2 = np4[2], a3 = np4[3];
            nv = (((a0[0] + a0[1]) + (a0[2] + a0[3])) + ((a1[0] + a1[1]) + (a1[2] + a1[3]))) + (((a2[0] + a2[1]) + (a2[2] + a2[3])) + ((a3[0] + a3[1]) + (a3[2] + a3[3]))); }
        nL[tid] = nv; }
    { float gi = 0.f, gf = 0.f; if (lane < L) { gi = GATES[(size_t)(row0 + lane) * 8 + h]; gf = GATES[(size_t)(row0 + lane) * 8 + 4 + h]; }
      const GateScan gs = gate_scan(gi, gf, p->bi[h], p->bf[h], lane < L, m_c, lane);
      if (wave == 0) { aL[lane] = gs.a; bmL[lane] = gs.b - gs.mt; interL[lane] = __expf(m_c + gs.b - gs.mt); emL[lane] = __expf(-gs.mt); } }
    LBAR();
    { const int mtw = wave >> 1, nh = wave & 1;
      f32x4 sa[2] = {(f32x4){0.f, 0.f, 0.f, 0.f}, (f32x4){0.f, 0.f, 0.f, 0.f}};
#pragma unroll
      for (int ks = 0; ks < 8; ++ks) { const bf16x8 A = *(const LAS bf16x8*)(Qs + (16 * mtw + i16) * QSTR + 32 * ks + 8 * kq);
#pragma unroll
          for (int nt = 0; nt < 2; ++nt) { const bf16x8 B = *(const LAS bf16x8*)(Ks + (32 * nh + 16 * nt + i16) * QSTR + 32 * ks + 8 * kq);
              sa[nt] = __builtin_amdgcn_mfma_f32_16x16x32_bf16(A, B, sa[nt], 0, 0, 0); } }
      float rs[4] = {0.f, 0.f, 0.f, 0.f};
#pragma unroll
      for (int nt = 0; nt < 2; ++nt) { const int s = 32 * nh + 16 * nt + i16; const float a_s = aL[s];
#pragma unroll
          for (int j = 0; j < 4; ++j) { const int t = 16 * mtw + 4 * kq + j; float v = 0.f;
              if (s <= t && t < L) v = sa[nt][j] * 0.0625f * __expf(a_s + bmL[t]);
              rs[j] += v; Ss[t * 72 + s] = (unsigned short)f2bf(v); } }
#pragma unroll
      for (int j = 0; j < 4; ++j) { const float v = row16_sum_dpp(rs[j]);
          if (i16 == 15) rsum[(16 * mtw + 4 * kq + j) * 2 + nh] = v; } }
    { const int t = tid >> 3, seg = tid & 7; float s = 0.f;
#pragma unroll
      for (int k8 = 0; k8 < 4; ++k8) { const v4u qw = *(const LAS v4u*)(Qs + t * QSTR + seg * 32 + 8 * k8);
          const f32x4 n0 = *(const LAS f32x4*)(nL + seg * 32 + 8 * k8), n1 = *(const LAS f32x4*)(nL + seg * 32 + 8 * k8 + 4);
          s += (bflo(qw.x) * n0[0] + bfhi(qw.x) * n0[1]) + (bflo(qw.y) * n0[2] + bfhi(qw.y) * n0[3]) + (bflo(qw.z) * n1[0] + bfhi(qw.z) * n1[1]) + (bflo(qw.w) * n1[2] + bfhi(qw.w) * n1[3]); }
      s = row8_sum_dpp(s);
      if (seg == 7) qdn[t] = s; }
    LBAR();
    f32x4 aV[4][2];
#pragma unroll
    for (int mt = 0; mt < 4; ++mt)
#pragma unroll
        for (int nt = 0; nt < 2; ++nt) aV[mt][nt] = (f32x4){0.f, 0.f, 0.f, 0.f};
    if (c > 0) {
#pragma unroll
        for (int ks = 0; ks < 4; ++ks) {
#pragma unroll
            for (int mt = 0; mt < 4; ++mt) { const bf16x8 A = *(const LAS bf16x8*)(Qs + (16 * mt + i16) * QSTR + 32 * ks + 8 * kq);
#pragma unroll
                for (int nt = 0; nt < 2; ++nt) aV[mt][nt] = __builtin_amdgcn_mfma_f32_16x16x32_bf16(A, bc[ks][nt], aV[mt][nt], 0, 0, 0); }
#pragma unroll
            for (int nt = 0; nt < 2; ++nt) bc[ks][nt] = *(const bf16x8*)(ct + (size_t)(16 * nt + i16) * 256 + 32 * (ks + 4) + 8 * kq);
            __builtin_amdgcn_sched_barrier(0); }
#pragma unroll
        for (int ks = 0; ks < 4; ++ks) {
#pragma unroll
            for (int mt = 0; mt < 4; ++mt) { const bf16x8 A = *(const LAS bf16x8*)(Qs + (16 * mt + i16) * QSTR + 32 * (ks + 4) + 8 * kq);
#pragma unroll
                for (int nt = 0; nt < 2; ++nt) aV[mt][nt] = __builtin_amdgcn_mfma_f32_16x16x32_bf16(A, bc[ks][nt], aV[mt][nt], 0, 0, 0); }
            __builtin_amdgcn_sched_barrier(0); }
#pragma unroll
        for (int mt = 0; mt < 4; ++mt) { const f32x4 i4 = *(const LAS f32x4*)(interL + 16 * mt + 4 * kq);
#pragma unroll
            for (int nt = 0; nt < 2; ++nt) aV[mt][nt] = aV[mt][nt] * i4; } }
    { const int q4 = i16 >> 2, p4 = lane & 3; const unsigned aVb = (unsigned)(size_t)Vs + (unsigned)(((8 * kq + q4) * QSTR + dv0 + 4 * p4) * 2);
      s16x4 rv[2][2][2];
      TR_READ(rv[0][0][0], aVb, 0); TR_READ(rv[0][0][1], aVb, 4 * QSTR * 2); TR_READ(rv[0][1][0], aVb, 32); TR_READ(rv[0][1][1], aVb, 4 * QSTR * 2 + 32);
      TR_READ(rv[1][0][0], aVb, 32 * QSTR * 2); TR_READ(rv[1][0][1], aVb, 36 * QSTR * 2); TR_READ(rv[1][1][0], aVb, 32 * QSTR * 2 + 32); TR_READ(rv[1][1][1], aVb, 36 * QSTR * 2 + 32);
      asm volatile("s_waitcnt lgkmcnt(0)" : "+v"(rv[0][0][0]), "+v"(rv[0][0][1]), "+v"(rv[0][1][0]), "+v"(rv[0][1][1]), "+v"(rv[1][0][0]), "+v"(rv[1][0][1]), "+v"(rv[1][1][0]), "+v"(rv[1][1][1]) :: "memory");
#pragma unroll
      for (int ks = 0; ks < 2; ++ks)
#pragma unroll
          for (int mt = 0; mt < 4; ++mt) { const bf16x8 A = *(const LAS bf16x8*)(Ss + (16 * mt + i16) * 72 + 32 * ks + 8 * kq);
#pragma unroll
              for (int nt = 0; nt < 2; ++nt) aV[mt][nt] = __builtin_amdgcn_mfma_f32_16x16x32_bf16(A, cat8(rv[ks][nt][0], rv[ks][nt][1]), aV[mt][nt], 0, 0, 0); } }
    v4u oreg[4];
#pragma unroll
    for (int pp = 0; pp < 4; ++pp) { const int q = tid + 512 * pp, t = q >> 5, ch = q & 31; oreg[pp] = t < L ? *(const v4u*)(P + (size_t)(row0 + t) * PW + 4096 + h * 256 + ch * 8) : (v4u){0u, 0u, 0u, 0u}; }
    LBAR();
#pragma unroll
    for (int mt = 0; mt < 4; ++mt)
#pragma unroll
        for (int j = 0; j < 4; ++j) { const int t = 16 * mt + 4 * kq + j; const float inter = interL[t]; const float qn = rsum[2 * t] + rsum[2 * t + 1] + inter * qdn[t];
            const float rden = 1.0f / fmaxf(fabsf(qn), emL[t]); float ssq = 0.f;
#pragma unroll
            for (int nt = 0; nt < 2; ++nt) { const float hv = aV[mt][nt][j] * rden; Hs[t * 260 + dv0 + 16 * nt + i16] = hv; ssq += hv * hv; }
            ssq = row16_sum_dpp(ssq);
            if (i16 == 15) hs[t * 8 + wave] = ssq; }
    LBAR();
#pragma unroll
    for (int pp = 0; pp < 4; ++pp) { const int q = tid + 512 * pp, t = q >> 5, ch = q & 31;
        if (t < L) { const f32x4 h0 = *(const LAS f32x4*)(hs + t * 8), h1 = *(const LAS f32x4*)(hs + t * 8 + 4);
            const float tot = ((h0[0] + h0[1]) + (h0[2] + h0[3])) + ((h1[0] + h1[1]) + (h1[2] + h1[3])); const float rstd = 1.0f / sqrtf(tot * (1.0f / 256.0f) + EPS);
            const f32x4 x0 = *(const LAS f32x4*)(Hs + t * 260 + 8 * ch), x1 = *(const LAS f32x4*)(Hs + t * 260 + 8 * ch + 4);
            const f32x4 g0 = *(const f32x4*)(p->gnorm + h * 256 + 8 * ch), g1 = *(const f32x4*)(p->gnorm + h * 256 + 8 * ch + 4);
            const v4u ov = oreg[pp]; v4u y;
            y.x = pk2(x0[0] * rstd * g0[0] * sigmoidf(bflo(ov.x)), x0[1] * rstd * g0[1] * sigmoidf(bfhi(ov.x))); y.y = pk2(x0[2] * rstd * g0[2] * sigmoidf(bflo(ov.y)), x0[3] * rstd * g0[3] * sigmoidf(bfhi(ov.y)));
            y.z = pk2(x1[0] * rstd * g1[0] * sigmoidf(bflo(ov.z)), x1[1] * rstd * g1[1] * sigmoidf(bfhi(ov.z))); y.w = pk2(x1[2] * rstd * g1[2] * sigmoidf(bflo(ov.w)), x1[3] * rstd * g1[3] * sigmoidf(bfhi(ov.w)));
            *(v4u*)(MIX + (size_t)(row0 + t) * DM + 1024 + h * 256 + 8 * ch) = y; }
        __builtin_amdgcn_sched_barrier(0); }
    LBAR();
}

__device__ __forceinline__ void unpack8(const v4u w, float (&f)[8]) { f[0] = bflo(w.x); f[1] = bfhi(w.x); f[2] = bflo(w.y); f[3] = bfhi(w.y); f[4] = bflo(w.z); f[5] = bfhi(w.z); f[6] = bflo(w.w); f[7] = bfhi(w.w); }
__device__ __forceinline__ void pool_rows(KP p, int lane, int gw, int NGW) {
    const bf16* P = (const bf16*)(p->ws + WS_P); bf16* D = (bf16*)(p->ws + WS_MIX);
    const int g = lane >> 4, w = 2 << g, ch0 = 16 * lane;
    for (int r = gw; r < R + 60 + 1920; r += NGW) {
        if (r < R) {
            int cnt, nloc, sb = 0, s = 0;
            if (r < RP) { const int t = r % TP; cnt = min(w, t + 1); nloc = cnt; }
            else { sb = (r - RP) >> 3; s = (r - RP) & 7; cnt = w; nloc = min(w, s + 1); }
#pragma unroll
            for (int half = 0; half < 2; ++half) { const int ch = ch0 + 8 * half; float sum[8], u0[8];
                v4u tb[16];
#pragma unroll
                for (int j = 0; j < 16; ++j) tb[j] = j < nloc ? *(const v4u*)(P + (size_t)(r - j) * PW + ch) : (v4u){0u, 0u, 0u, 0u};
                unpack8(tb[0], u0);
#pragma unroll
                for (int e = 0; e < 8; ++e) sum[e] = u0[e];
#pragma unroll
                for (int j = 1; j < 16; ++j) { float f[8]; unpack8(tb[j], f);
#pragma unroll
                    for (int e = 0; e < 8; ++e) sum[e] += f[e]; }
                for (int j = nloc; j < cnt; ++j) { const float* sp = p->spool + ((size_t)sb * 15 + (15 + s - j)) * 1024 + ch; const f32x4 a = *(const f32x4*)sp, bq = *(const f32x4*)(sp + 4);
                    sum[0] += a[0]; sum[1] += a[1]; sum[2] += a[2]; sum[3] += a[3]; sum[4] += bq[0]; sum[5] += bq[1]; sum[6] += bq[2]; sum[7] += bq[3]; }
                const float ic = 1.0f / (float)cnt; v4u o;
                o.x = pk2(sum[0] * ic - u0[0], sum[1] * ic - u0[1]); o.y = pk2(sum[2] * ic - u0[2], sum[3] * ic - u0[3]); o.z = pk2(sum[4] * ic - u0[4], sum[5] * ic - u0[5]); o.w = pk2(sum[6] * ic - u0[6], sum[7] * ic - u0[7]);
                *(v4u*)(D + (size_t)r * DM + ch) = o; }
        } else if (r < R + 60) {
            const int q = r - R, bb = q / 15, i = q % 15; const bf16* src = P + (size_t)(bb * TP + TP - 15 + i) * PW + ch0; float* dst = p->out + O_POOLP + (size_t)q * 1024 + ch0;
#pragma unroll
            for (int half = 0; half < 2; ++half) { float f[8]; unpack8(*(const v4u*)(src + 8 * half), f); *(f32x4*)(dst + 8 * half) = (f32x4){f[0], f[1], f[2], f[3]}; *(f32x4*)(dst + 8 * half + 4) = (f32x4){f[4], f[5], f[6], f[7]}; }
        } else {
            const int q = r - R - 60, sb = q / 15, i = q % 15; float* dst = p->out + O_POOLS + (size_t)q * 1024 + ch0;
            if (i < 7) { const float* src = p->spool + ((size_t)sb * 15 + 8 + i) * 1024 + ch0;
#pragma unroll
                for (int e = 0; e < 4; ++e) *(f32x4*)(dst + 4 * e) = *(const f32x4*)(src + 4 * e); }
            else { const bf16* src = P + (size_t)(RP + sb * 8 + i - 7) * PW + ch0;
#pragma unroll
                for (int half = 0; half < 2; ++half) { float f[8]; unpack8(*(const v4u*)(src + 8 * half), f); *(f32x4*)(dst + 8 * half) = (f32x4){f[0], f[1], f[2], f[3]}; *(f32x4*)(dst + 8 * half + 4) = (f32x4){f[4], f[5], f[6], f[7]}; } }
        }
    }
}

struct Args { Ptrs p; int ph_lo, ph_hi; };
#ifndef PG8_SP2
#define PG8_SP2 true
#endif
#ifndef PG8_ALIGN
#define PG8_ALIGN true
#endif
__global__ void __launch_bounds__(NTHR, 2) mk_fwd(Args args) {
    extern __shared__ __attribute__((aligned(16))) unsigned char lds_raw[];
    LAS unsigned char* lds = (LAS unsigned char*)lds_raw;
    const int tid = threadIdx.x, lane = tid & 63, wave = __builtin_amdgcn_readfirstlane(tid >> 6), G = gridDim.x;
    typedef const __attribute__((address_space(4))) Args* KA;
#define KARGS() ({ KA k_ = (KA)__builtin_amdgcn_kernarg_segment_ptr(); asm volatile("" : "+s"(k_)); k_; })
    const int lo = KARGS()->ph_lo, hi = KARGS()->ph_hi;
    cg::grid_group grid = cg::this_grid();
    volatile LAS unsigned* bst = (volatile LAS unsigned*)(lds + LDS_BYTES - 64);
    if (tid < 2) bst[tid] = 0u;
    __syncthreads();
    XcdBarrier xbar = xcd_barrier_post((unsigned*)(KARGS()->p.ws + WS_CTL), bst);
    if (hi == 0x7fff) grid.sync();
#ifndef PH_MASK
#define PH_MASK 0x1ff
#endif
#define IN(k) (((PH_MASK >> (k)) & 1) && lo <= (k) && (k) < hi)
#define SEAM(k) do { if (IN(k) && IN((k) + 1)) xcd_barrier(xbar); } while (0)
#define PHASE_PTRS() KP p = &KARGS()->p; unsigned char* ws = p->ws; (void)ws
    if (IN(0)) { PHASE_PTRS(); p0_prologue(p, lds, tid, lane, wave, G); }
#if defined(PROBE) && (PROBE == 1 || PROBE == 2)
    if (IN(0)) { xcd_barrier(xbar); PHASE_PTRS(); p0_prologue(p, lds, tid, lane, wave, G, PROBE); }
#elif defined(PROBE) && PROBE == 9
    if (IN(0)) { for (int q = 0; q < 10; ++q) xcd_barrier(xbar); }
#endif
    SEAM(0);
    if (IN(1)) { PHASE_PTRS(); pg8::Gemm g{(const bf16*)(ws + WS_XN), (const bf16*)(ws + WS_WIN), MP, PW, DM, DM, 0}; pg8::StaticOrder S; S.init(MP, PW, G, (int)blockIdx.x);
        pg8::EpiBf16 E{(bf16*)(ws + WS_P), PW}; pg8::gemm_phase<pg8::EpiBf16, pg8::StaticOrder, PG8_ALIGN, PG8_SP2>(lds, g, S, E);
        if (G == 256) { int k256 = 256; asm volatile("" : "+s"(k256));
            pg8::Gemm gf{(const bf16*)(ws + WS_WOUT), (const bf16*)(ws + WS_WP), DM, 1024, k256, DM, 512}; pg8::FoldOrder SF{(int)blockIdx.x - 228};
            pg8::EpiBf16 EF{(bf16*)(ws + WS_WOUT), DM}; pg8::gemm_phase<pg8::EpiBf16, pg8::FoldOrder, PG8_ALIGN, PG8_SP2>(lds, gf, SF, EF); } }
    SEAM(1);
    if (IN(2)) { PHASE_PTRS();
        const int bx = blockIdx.x;
        if (bx < 128) chain_unit(p, lds, tid, lane, wave, bx >> 3, bx & 7);
        { const int su0 = G > 128 ? bx - 128 : bx, sstep = G > 128 ? G - 128 : G;
          if (su0 >= 0 && su0 < 512) { SampPre cur; samp_load(p, tid, lane, wave, su0, cur);
#pragma unroll 1
              for (int su = su0; su < 512; su += sstep) { SampPre nx = cur; if (su + sstep < 512) samp_load(p, tid, lane, wave, su + sstep, nx);
                  sample_unit<true, false>(p, lds, tid, lane, wave, su, cur); cur = nx; } } }
        if (G < 128) for (int cu = bx + G; cu < 128; cu += G) chain_unit(p, lds, tid, lane, wave, cu >> 3, cu & 7);
    }
#if defined(PROBE) && PROBE == 21
    if (IN(2)) { xcd_barrier(xbar); PHASE_PTRS(); const int bx = blockIdx.x; if (bx < 128) chain_unit(p, lds, tid, lane, wave, bx >> 3, bx & 7); }
#elif defined(PROBE) && PROBE == 22
    if (IN(2)) { xcd_barrier(xbar); PHASE_PTRS(); const int bx = blockIdx.x; { } }
#endif
    SEAM(2);
    if (IN(3)) { PHASE_PTRS();
        for (int u = blockIdx.x; u < 16 * NCH; u += G) prompt_out_unit(p, lds, tid, lane, wave, u / NCH, u % NCH);
        if (G > 32) { if (blockIdx.x >= 16) pool_rows(p, lane, (blockIdx.x - 16) * NWAVES + wave, (G - 16) * NWAVES); }
        else pool_rows(p, lane, blockIdx.x * NWAVES + wave, G * NWAVES);
    }
#if defined(PROBE) && PROBE == 31
    if (IN(3)) { xcd_barrier(xbar); PHASE_PTRS(); for (int u = blockIdx.x; u < 16 * NCH; u += G) prompt_out_unit(p, lds, tid, lane, wave, u / NCH, u % NCH); }
#elif defined(PROBE) && PROBE == 32
    if (IN(3)) { xcd_barrier(xbar); PHASE_PTRS(); pool_rows(p, lane, blockIdx.x * NWAVES + wave, G * NWAVES); }
#endif
    SEAM(3);

    if (IN(5)) { PHASE_PTRS(); pg8::Gemm g{(const bf16*)(ws + WS_MIX), (const bf16*)(ws + WS_WOUT), MP, DM, DM, DM, 0};
        pg8::EpiOut E{(float*)(ws + WS_X1), (bf16*)(ws + WS_XN), (float*)(ws + WS_SS1), pg8::RowMap{p->xp, p->xs, p->meta, nullptr, nullptr}};
#pragma unroll 1
        for (int st = 0; st < 2; ++st) { pg8::OutOrder S{(int)blockIdx.x, st}; pg8::gemm_phase<pg8::EpiOut, pg8::OutOrder, PG8_ALIGN, PG8_SP2>(lds, g, S, E); if (st == 0) xcd_barrier(xbar); }
    }
    if (IN(6)) { PHASE_PTRS(); pg8::Gemm g{(const bf16*)(ws + WS_XN), (const bf16*)(ws + WS_WGU), MP, 2 * DFF, DM, DM, 0};
        pg8::EpiGU E{(bf16*)(ws + WS_H), DFF, (const float*)(ws + WS_SS1), EPS};
#pragma unroll 1
        for (int st = 0; st < 2; ++st) { pg8::GuOrder S{(int)blockIdx.x, st}; pg8::gemm_phase<pg8::EpiGU, pg8::GuOrder, PG8_ALIGN, PG8_SP2>(lds, g, S, E);
            if (st == 0) { if (blockIdx.x >= 132) for (int uu = blockIdx.x - 132; uu < 248; uu += 124) upd2_unit(p, lds, tid, lane, wave, uu); xcd_barrier(xbar); } }
    }
    SEAM(6);
    if (IN(7)) { PHASE_PTRS(); pg8::Gemm g{(const bf16*)(ws + WS_H), (const bf16*)(ws + WS_WD), MP, DM, DFF, DFF, 0}; pg8::DownOrder S{(int)blockIdx.x};
        pg8::EpiDown E{(const float*)(ws + WS_X1), (float*)(ws + WS_SLAB), pg8::RowMap{nullptr, nullptr, nullptr, p->out + O_YP, p->out + O_YS}};
        pg8::gemm_phase<pg8::EpiDown, pg8::DownOrder, PG8_ALIGN, PG8_SP2>(lds, g, S, E);
        if (blockIdx.x >= 160 && blockIdx.x < 168) upd2_unit(p, lds, tid, lane, wave, 248 + (int)blockIdx.x - 160); }
    SEAM(7);
    if (IN(8)) { PHASE_PTRS();
        const float* X1 = (const float*)(ws + WS_X1); const float* slab = (const float*)(ws + WS_SLAB); const float* nfin = p->nfinal; float* yb = p->out + O_YP;
        const int gw = blockIdx.x * NWAVES + wave, NGW = G * NWAVES;
#define P8_ROW(o_) ((o_) < 8192 ? ((o_) >> 11) * TP + 16 + ((o_) & 2047) : RP + ((o_) - 8192))
        f32x4 vn[8];
        if (gw < 9216 && P8_ROW(gw) < 8192) { const f32x4* y4 = (const f32x4*)(yb + (size_t)gw * DM) + lane;
#pragma unroll
            for (int j = 0; j < 8; ++j) vn[j] = y4[64 * j]; }
        for (int o = gw; o < 9216; o += NGW) { const int r = P8_ROW(o);
            f32x4* y4 = (f32x4*)(yb + (size_t)o * DM) + lane; f32x4 v[8]; float s = 0.f;
            if (r < 8192) {
#pragma unroll
                for (int j = 0; j < 8; ++j) v[j] = vn[j];
            } else { const f32x4* x4 = (const f32x4*)(X1 + (size_t)r * DM) + lane; const f32x4* s4 = (const f32x4*)(slab + (size_t)(r - 8192) * DM) + lane;
#pragma unroll
                for (int j = 0; j < 8; ++j) v[j] = x4[64 * j] + ((s4[64 * j] + s4[64 * j + 1280 * DM / 4]) + (s4[64 * j + 2 * (1280 * DM / 4)] + s4[64 * j + 3 * (1280 * DM / 4)])); }
            const int on = o + NGW;
            if (on < 9216 && P8_ROW(on) < 8192) { const f32x4* yn = (const f32x4*)(yb + (size_t)on * DM) + lane;
#pragma unroll
                for (int j = 0; j < 8; ++j) vn[j] = yn[64 * j]; }
#pragma unroll
            for (int j = 0; j < 8; ++j) s += (v[j][0] * v[j][0] + v[j][1] * v[j][1]) + (v[j][2] * v[j][2] + v[j][3] * v[j][3]);
            const float rstd = 1.0f / sqrtf(wave_sum(s) * (1.0f / DM) + EPS);
#pragma unroll
            for (int j = 0; j < 8; ++j) { const f32x4 w4 = ((const f32x4*)nfin)[64 * j + lane]; y4[64 * j] = v[j] * rstd * w4; } }
#undef P8_ROW
    }
#undef IN
#undef SEAM
}

extern "C" void kernel_launch(void* const* d_in, const int* in_sizes, int n_in, void* d_out, int out_size, void* d_ws, size_t ws_size, hipStream_t stream) {
    static int grid = 0;
    if (grid == 0) {
        if (n_in != 20 || (size_t)out_size != O_END || ws_size < WS_END) { fprintf(stderr, "kernel_launch: unexpected shapes: n_in %d out %d ws %zu\n", n_in, out_size, ws_size); grid = -1; return; }
        int dev = 0, cus = 0, per_cu = 0;
        (void)hipGetDevice(&dev); (void)hipDeviceGetAttribute(&cus, hipDeviceAttributeMultiprocessorCount, dev);
        if (hipFuncSetAttribute((const void*)mk_fwd, hipFuncAttributeMaxDynamicSharedMemorySize, LDS_BYTES) != hipSuccess) { fprintf(stderr, "kernel_launch: hipFuncSetAttribute failed\n"); grid = -1; return; }
        if (hipOccupancyMaxActiveBlocksPerMultiprocessor(&per_cu, (const void*)mk_fwd, NTHR, LDS_BYTES) != hipSuccess || per_cu < 1) { fprintf(stderr, "kernel_launch: occupancy query gave %d\n", per_cu); (void)hipGetLastError(); per_cu = 1; }
        if (cus < 256) { fprintf(stderr, "kernel_launch: needs 256 CUs, found %d\n", cus); grid = -1; return; }
        grid = 256;
    }
    if (grid < 0) return;
    Args a{};
    const float** pp = (const float**)&a.p;
    for (int i = 0; i < 20; ++i) pp[i] = (const float*)d_in[i];
    a.p.out = (float*)d_out; a.p.ws = (unsigned char*)d_ws;
#if ONE_LAUNCH
    if (hipMemsetAsync((char*)d_ws + WS_CTL, 0, CTL_BYTES, stream) != hipSuccess) { fprintf(stderr, "kernel_launch: memset failed\n"); return; }
    a.ph_lo = 0; a.ph_hi = 9;
    void* kargs[] = {&a};
    hipError_t e = hipLaunchCooperativeKernel((const void*)mk_fwd, dim3(grid), dim3(NTHR), kargs, LDS_BYTES, stream);
    if (e != hipSuccess) fprintf(stderr, "cooperative launch failed: %s (grid %d)\n", hipGetErrorString(e), grid);
#else
    for (int ph = 0; ph < 9; ++ph) { a.ph_lo = ph; a.ph_hi = ph + 1; hipLaunchKernelGGL(mk_fwd, dim3(grid), dim3(NTHR), LDS_BYTES, stream, a); }
#endif
}
```
